# Optimizing an MI355X kernel written in HIP

```python
import math
import jax
import jax.numpy as jnp
from jax import lax
import numpy as np

D_MODEL = 1024
BATCH = 16
SEQ = 256
DEPTH = 4
DEC_BATCH = 8
DEC_SEQ = 2048
PAST_LEN = 512

GRID_W = 64
D_A = D_MODEL
FOURIER_GROUPS = 4
FOURIER_GROUP_DIM = D_A // FOURIER_GROUPS
D_B = D_MODEL
CONV_K = 3
FC_IN = 2 * D_A + 4 * D_B
SSD_EXPAND = 2
SSD_D_INNER = SSD_EXPAND * D_MODEL
SSD_HEAD_DIM = 64
SSD_HEADS = SSD_D_INNER // SSD_HEAD_DIM
SSD_GROUPS = 8
SSD_D_STATE = 128
SSD_CONV_DIM = SSD_D_INNER + 2 * SSD_GROUPS * SSD_D_STATE
SSD_IN = SSD_D_INNER + SSD_CONV_DIM + 2 * SSD_HEADS
CHUNK = 128
EPS = 1e-6

kernel_name = "hybrid_fourier_shortconv_ssd_diffusion_step"


def rmsnorm(x, g):
    xf = x.astype(jnp.float32)
    y = xf * lax.rsqrt(jnp.mean(xf * xf, axis=-1, keepdims=True) + EPS)
    return (y * g.astype(jnp.float32)).astype(x.dtype)


def dwconv3(u, w, rows, row_len):
    bsz, L, C = u.shape
    ug = u.reshape(bsz, rows, row_len, C)
    up = jnp.pad(ug, ((0, 0), (0, 0), (1, 1), (0, 0)))
    y = up[:, :, :-2] * w[0] + up[:, :, 1:-1] * w[1] + up[:, :, 2:] * w[2]
    return y.reshape(bsz, L, C)


def fc_mixer(h, w_in, conv_w, w_out, rows, row_len):
    bsz, L, _ = h.shape
    proj = h @ w_in
    u_a, z_a, b_b, c_b, v_b, z_b = jnp.split(proj, 6, axis=-1)
    ua = u_a.astype(jnp.float32).reshape(bsz, L, FOURIER_GROUPS, FOURIER_GROUP_DIM)
    y_a = jnp.fft.fftn(ua, axes=(1, 3), norm="ortho").real.reshape(bsz, L, D_A).astype(h.dtype)
    y_a = y_a * jax.nn.silu(z_a)
    y_b = b_b * dwconv3(c_b * v_b, conv_w, rows, row_len)
    y_b = y_b * jax.nn.silu(z_b)
    return jnp.concatenate([y_a, y_b], axis=-1) @ w_out


def ssd_scan(x, dt, a, b_in, c_in, h0):
    bsz, L, H, P = x.shape
    G, N = b_in.shape[2], b_in.shape[3]
    R = H // G
    nc = L // CHUNK
    xd = (x * dt[..., None]).reshape(bsz, nc, CHUNK, G, R, P)
    la_cum = jnp.cumsum((dt * a).reshape(bsz, nc, CHUNK, G, R), axis=2)
    bc = b_in.reshape(bsz, nc, CHUNK, G, N)
    cc = c_in.reshape(bsz, nc, CHUNK, G, N)
    causal = jnp.tril(jnp.ones((CHUNK, CHUNK), dtype=bool))[None, None, :, :, None, None]
    seg = la_cum[:, :, :, None] - la_cum[:, :, None, :]
    decay = jnp.exp(jnp.where(causal, seg, -jnp.inf))
    cb = jnp.einsum('bclgn,bcsgn->bclsg', cc, bc)
    y_diag = jnp.einsum('bclsgr,bcsgrp->bclgrp', decay * cb[..., None], xd)
    decay_to_end = jnp.exp(la_cum[:, :, -1:] - la_cum)
    st = jnp.einsum('bclgn,bclgr,bclgrp->bcgrpn', bc, decay_to_end, xd)
    chunk_decay = jnp.exp(la_cum[:, :, -1])

    def step(hc, inp):
        st_c, dec_c = inp
        return hc * dec_c[..., None, None] + st_c, hc

    h_final, h_in = lax.scan(step, h0.reshape(bsz, G, R, P, N),
                             (jnp.swapaxes(st, 0, 1), jnp.swapaxes(chunk_decay, 0, 1)))
    h_in = jnp.swapaxes(h_in, 0, 1)
    y_off = jnp.einsum('bclgn,bcgrpn,bclgr->bclgrp', cc, h_in, jnp.exp(la_cum))
    y = (y_diag + y_off).reshape(bsz, L, H, P)
    return y, h_final.reshape(bsz, H, P, N)


def ssd_mixer(h, w_in, conv_w, conv_b, dt_bias, a_log, d_skip, norm_g, w_out, h0_f, h0_b):
    bsz, L, _ = h.shape
    proj = h @ w_in
    z = proj[..., :SSD_D_INNER]
    xbc = proj[..., SSD_D_INNER:SSD_D_INNER + SSD_CONV_DIM]
    dt_raw = proj[..., SSD_D_INNER + SSD_CONV_DIM:]
    xbc = jax.nn.silu(dwconv3(xbc, conv_w, 1, L) + conv_b).astype(jnp.float32)
    xs = xbc[..., :SSD_D_INNER].reshape(bsz, L, SSD_HEADS, SSD_HEAD_DIM)
    bs = xbc[..., SSD_D_INNER:SSD_D_INNER + SSD_GROUPS * SSD_D_STATE].reshape(bsz, L, SSD_GROUPS, SSD_D_STATE)
    cs = xbc[..., SSD_D_INNER + SSD_GROUPS * SSD_D_STATE:].reshape(bsz, L, SSD_GROUPS, SSD_D_STATE)
    dt = jax.nn.softplus(dt_raw.astype(jnp.float32).reshape(bsz, L, 2, SSD_HEADS)
                         + dt_bias.astype(jnp.float32))
    a = -jnp.exp(a_log.astype(jnp.float32))
    y_f, hf = ssd_scan(xs, dt[:, :, 0], a[0], bs, cs, h0_f.astype(jnp.float32))
    flip = lambda t: jnp.flip(t, axis=1)
    y_b, hb = ssd_scan(flip(xs), flip(dt[:, :, 1]), a[1], flip(bs), flip(cs), h0_b.astype(jnp.float32))
    y = y_f + flip(y_b) + d_skip.astype(jnp.float32)[:, None] * xs
    y = y.reshape(bsz, L, SSD_D_INNER) * jax.nn.silu(z.astype(jnp.float32))
    yg = y.reshape(bsz, L, SSD_GROUPS, SSD_D_INNER // SSD_GROUPS)
    yg = yg * lax.rsqrt(jnp.mean(yg * yg, axis=-1, keepdims=True) + EPS)
    y = yg.reshape(bsz, L, SSD_D_INNER) * norm_g.astype(jnp.float32)
    return y.astype(h.dtype) @ w_out, hf.astype(h.dtype), hb.astype(h.dtype)


def trunk(x, cond, rows, row_len, h0, w_mod, b_mod, norm_g, fc_w_in, fc_conv_w, fc_w_out,
          ssd_w_in, ssd_conv_w, ssd_conv_b, ssd_dt_bias, ssd_a_log, ssd_d, ssd_norm_g,
          ssd_w_out, final_norm_g):
    cond_act = jax.nn.silu(cond)
    states = []
    for layer in range(DEPTH):
        shift, scale, gate = jnp.split(cond_act @ w_mod[layer] + b_mod[layer], 3, axis=-1)
        hm = rmsnorm(x, norm_g[layer]) * (1 + scale[:, None]) + shift[:, None]
        i = layer // 2
        if layer % 2 == 0:
            out = fc_mixer(hm, fc_w_in[i], fc_conv_w[i], fc_w_out[i], rows, row_len)
        else:
            out, hf, hb = ssd_mixer(hm, ssd_w_in[i], ssd_conv_w[i], ssd_conv_b[i], ssd_dt_bias[i],
                                    ssd_a_log[i], ssd_d[i], ssd_norm_g[i], ssd_w_out[i],
                                    h0[:, i, 0], h0[:, i, 1])
            states.append(jnp.stack([hf, hb], axis=1))
        x = x + gate[:, None] * out
    return rmsnorm(x, final_norm_g), jnp.stack(states, axis=1)


def setup_inputs(seed: int = 0) -> dict:
    key = jax.random.key(seed)
    ks = jax.random.split(key, 24)
    nrm = lambda k, shape, s: jax.random.normal(k, shape, jnp.float32) * s
    ne = (DEPTH + 1) // 2
    no = DEPTH // 2
    dt0 = jnp.exp(jax.random.uniform(ks[14], (no, 2, SSD_HEADS), jnp.float32,
                                     minval=math.log(1e-3), maxval=math.log(1e-1)))
    return {
        "x_prompt": nrm(ks[0], (BATCH, SEQ, D_MODEL), 1.0),
        "x_sample": nrm(ks[1], (DEC_BATCH, DEC_SEQ, D_MODEL), 1.0),
        "state_ssm": nrm(ks[2], (DEC_BATCH, no, 2, SSD_HEADS, SSD_HEAD_DIM, SSD_D_STATE), 0.3),
        "c": nrm(ks[3], (DEC_BATCH, D_MODEL), 1.0),
        "c_ctx": nrm(ks[4], (D_MODEL,), 1.0),
        "w_mod": nrm(ks[5], (DEPTH, D_MODEL, 3 * D_MODEL), D_MODEL ** -0.5),
        "b_mod": nrm(ks[6], (DEPTH, 3 * D_MODEL), 0.02),
        "norm_g": 1.0 + nrm(ks[7], (DEPTH, D_MODEL), 0.02),
        "fc_w_in": nrm(ks[8], (ne, D_MODEL, FC_IN), D_MODEL ** -0.5),
        "fc_conv_w": nrm(ks[9], (ne, CONV_K, D_B), CONV_K ** -0.5),
        "fc_w_out": nrm(ks[10], (ne, D_A + D_B, D_MODEL), (D_A + D_B) ** -0.5),
        "ssd_w_in": nrm(ks[11], (no, D_MODEL, SSD_IN), D_MODEL ** -0.5),
        "ssd_conv_w": nrm(ks[12], (no, CONV_K, SSD_CONV_DIM), CONV_K ** -0.5),
        "ssd_conv_b": nrm(ks[13], (no, SSD_CONV_DIM), 0.02),
        "ssd_dt_bias": dt0 + jnp.log(-jnp.expm1(-dt0)),
        "ssd_a_log": jnp.log(jax.random.uniform(ks[15], (no, 2, SSD_HEADS), jnp.float32, minval=1.0, maxval=16.0)),
        "ssd_d": 1.0 + nrm(ks[16], (no, SSD_HEADS), 0.1),
        "ssd_norm_g": 1.0 + nrm(ks[17], (no, SSD_D_INNER), 0.02),
        "ssd_w_out": nrm(ks[18], (no, SSD_D_INNER, D_MODEL), SSD_D_INNER ** -0.5),
        "final_norm_g": 1.0 + nrm(ks[19], (D_MODEL,), 0.02),
    }


def reference(x_prompt, x_sample, state_ssm, c, c_ctx, w_mod, b_mod, norm_g, fc_w_in, fc_conv_w,
              fc_w_out, ssd_w_in, ssd_conv_w, ssd_conv_b, ssd_dt_bias, ssd_a_log, ssd_d,
              ssd_norm_g, ssd_w_out, final_norm_g):
    params = (w_mod, b_mod, norm_g, fc_w_in, fc_conv_w, fc_w_out, ssd_w_in, ssd_conv_w,
              ssd_conv_b, ssd_dt_bias, ssd_a_log, ssd_d, ssd_norm_g, ssd_w_out, final_norm_g)
    h0_ctx = jnp.zeros((x_prompt.shape[0],) + state_ssm.shape[1:], x_prompt.dtype)
    y_prompt, new_state_ssm = trunk(x_prompt, c_ctx[None, :], 1, x_prompt.shape[1], h0_ctx, *params)
    rows = x_sample.shape[1] // GRID_W
    y_sample, _ = trunk(x_sample, c, rows, GRID_W, state_ssm, *params)
    return (y_prompt, y_sample, new_state_ssm)
```

```cpp
#include <hip/hip_runtime.h>
#include <hip/hip_cooperative_groups.h>
#include <cstdio>
#include <cstring>
namespace cg = cooperative_groups;

#define LAS __attribute__((address_space(3)))
typedef unsigned short bf16_t;
typedef short bf16x8 __attribute__((ext_vector_type(8)));
typedef float f32x4 __attribute__((ext_vector_type(4)));
typedef unsigned u32x4 __attribute__((ext_vector_type(4)));
typedef unsigned u32x2 __attribute__((ext_vector_type(2)));

constexpr int TOK = 20480, TOKC = 4096;
constexpr size_t SLOT = 2097152;
constexpr size_t OUT_STATE_OFF = (size_t)TOK * 1024;

constexpr size_t WS_BAR = 0;
constexpr size_t WS_MOD = 16384;
constexpr size_t WS_TC = 524288;
constexpr size_t WS_ALC = 786432;
constexpr size_t WS_WF = 1048576;
constexpr size_t WS_BIG = 9437184;
constexpr size_t WS_WUBF = WS_BIG;
constexpr size_t E_VTC = WS_BIG;
constexpr size_t E_VTL = E_VTC + 16777216;
constexpr size_t E_ZA = WS_BIG + 83886080;
constexpr size_t E_YB = E_ZA + 41943040;
constexpr int E_T0 = 38, E_T1 = 42;
constexpr size_t E_PS = (size_t)E_T1 * 256 * 2048;
constexpr size_t E_HM = E_YB + 41943040;
constexpr size_t E_PL = E_HM + E_PS;
constexpr size_t E_YA = E_PL;
constexpr size_t E_END = E_PL + 4 * E_PS;
constexpr size_t O_WIN = WS_BIG;
constexpr size_t O_WOUT = O_WIN + 13107200;
constexpr size_t O_HM = O_WOUT + 4194304;
constexpr size_t O_YN = O_HM + 41943040;
constexpr size_t O_DTR = O_YN + 83886080;
constexpr size_t O_Z = O_DTR + 5242880;
constexpr size_t O_RAWX = O_Z + 20971520;
constexpr size_t O_RAWB = O_RAWX + 20971520;
constexpr size_t O_RAWC = O_RAWB + 10485760;
constexpr size_t O_XT = O_RAWC + 10485760;
constexpr size_t O_BS = O_XT + 20971520;
constexpr size_t O_BT = O_BS + 10485760;
constexpr size_t O_CS = O_BT + 10485760;
constexpr size_t O_ST = O_XT;
constexpr size_t O_YD = O_CS + 10485760;
constexpr size_t O_CUM = O_YD + 20971520;
constexpr size_t O_DEC = O_CUM + 1310720;
constexpr size_t O_END = O_DEC + 16384;
constexpr size_t WS_NEED = (O_END > E_END ? O_END : E_END);

constexpr int LDS_BYTES = 147520;

struct P {
    const float *x_prompt, *x_sample, *state, *c, *c_ctx, *w_mod, *b_mod, *norm_g, *fc_w_in, *fc_conv_w, *fc_w_out, *ssd_w_in, *ssd_conv_w,
        *ssd_conv_b, *ssd_dt_bias, *ssd_a_log, *ssd_d, *ssd_norm_g, *ssd_w_out, *final_norm_g;
    float* out; unsigned char* ws; int ph0, ph1;
};

typedef __bf16 bf16v2 __attribute__((ext_vector_type(2)));
typedef float f32x2 __attribute__((ext_vector_type(2)));
__device__ __forceinline__ unsigned cvt_pk(float lo, float hi) { const f32x2 v = {lo, hi}; const bf16v2 b = __builtin_convertvector(v, bf16v2); return __builtin_bit_cast(unsigned, b); }
__device__ __forceinline__ float bflo(unsigned u) { return __uint_as_float(u << 16); }
__device__ __forceinline__ float bfhi(unsigned u) { return __uint_as_float(u & 0xFFFF0000u); }
__device__ __forceinline__ float bf2f(short s) { return __uint_as_float(((unsigned)(unsigned short)s) << 16); }
__device__ __forceinline__ float silu_f(float x) { return x * __builtin_amdgcn_rcpf(1.0f + __expf(-x)); }
__device__ __forceinline__ unsigned char* slot_ptr(const P& p, int b, int i) { return (unsigned char*)(p.out + OUT_STATE_OFF) + ((size_t)b * 2 + i) * SLOT; }
__device__ __forceinline__ int cond_of_tile(int pm) { return pm < 16 ? 0 : 1 + ((pm - 16) >> 3); }
__device__ __forceinline__ int cond_of_tok(int tok) { return tok < TOKC ? 0 : 1 + ((tok - TOKC) >> 11); }

__device__ __forceinline__ int otid() { int t; asm volatile("v_mov_b32 %0, %1" : "=v"(t) : "v"((int)threadIdx.x)); return t; }
__device__ __forceinline__ int frag_off(int fr, int fq) { int ob = fr * 64 + fq * 16; return ob ^ (((ob >> 9) & 1) << 5); }
__device__ __forceinline__ void stage_tile(LAS unsigned char* lds, int ldsoff, const unsigned char* g, long ldb, int R16, int K32, int wid, int lane) {
    const int b = lane * 16, swz = b ^ (((b >> 9) & 1) << 5), rr = swz >> 6, cc = (swz & 63) >> 1;
    for (int st = wid; st < R16 * K32; st += 8) {
        const int rb = st / K32, kb = st - rb * K32;
        const unsigned char* src = g + (long)(rb * 16 + rr) * ldb + (kb * 32 + cc) * 2;
        __builtin_amdgcn_global_load_lds((const unsigned*)src, (LAS unsigned*)(lds + ldsoff + st * 1024), 16, 0, 0);
    }
}
#define LDFRAG(lds, off) (*(const LAS bf16x8*)((lds) + (off)))
typedef short s16x4 __attribute__((ext_vector_type(4)));
__device__ __forceinline__ unsigned off_b(unsigned row, unsigned ch) { return 256u * row + 16u * (ch ^ (((row & 3u) << 2) | ((row >> 2) & 3u))); }
__device__ __forceinline__ void stage_img(LAS unsigned char* lds, int ldsoff, const unsigned char* g, long ld, int wid, int lane) {
    const unsigned rr = lane >> 4, pch = lane & 15;
    for (int i = wid; i < 32; i += 8) { const unsigned row = 4 * i + rr, ch = pch ^ (((row & 3u) << 2) | ((row >> 2) & 3u));
        __builtin_amdgcn_global_load_lds((const unsigned*)(g + (long)row * ld + ch * 16), (LAS unsigned*)(lds + ldsoff + i * 1024), 16, 0, 0); }
}
__device__ __forceinline__ bf16x8 trfrag(LAS unsigned char* img, int lane, int c, int ks) {
    const unsigned g = lane >> 4, q = (lane & 15) >> 2, pp = lane & 3;
    const unsigned a0 = off_b(32 * ks + 8 * g + q, 2 * c + (pp >> 1)) + 8 * (pp & 1), a1 = off_b(32 * ks + 8 * g + 4 + q, 2 * c + (pp >> 1)) + 8 * (pp & 1);
    const s16x4 x = __builtin_amdgcn_ds_read_tr16_b64_v4i16((LAS s16x4*)(img + a0)), y = __builtin_amdgcn_ds_read_tr16_b64_v4i16((LAS s16x4*)(img + a1));
    return (bf16x8){x[0], x[1], x[2], x[3], y[0], y[1], y[2], y[3]};
}
#define MFMA(a, b, c) __builtin_amdgcn_mfma_f32_16x16x32_bf16((a), (b), (c), 0, 0, 0)

#define XB_TMO      128
#define XB_XCNT(j)  (256  + 64 * (j))
#define XB_XSUB(j)  (1280 + 64 * (j))
#define XB_XGEN(j)  (2304 + 64 * (j))
#define XB_TOP      3328
#define XB_TOPGEN   3392
#define XB_SPIN_CAP (1u << 22)
__device__ __forceinline__ unsigned xb_ld(unsigned* p)              { return __hip_atomic_load(p, __ATOMIC_RELAXED, __HIP_MEMORY_SCOPE_AGENT); }
__device__ __forceinline__ unsigned xb_add(unsigned* p, unsigned v) { return __hip_atomic_fetch_add(p, v, __ATOMIC_RELAXED, __HIP_MEMORY_SCOPE_AGENT); }
__device__ __forceinline__ unsigned xb_xcc_id() { return (unsigned)__builtin_amdgcn_s_getreg((3 << 11) | 20) & 0xFu; }
#define XB_SPIN(cond, bar) do { unsigned _sp = 0; while (cond) { __builtin_amdgcn_s_sleep(1); \
    if ((++_sp & 255u) == 0u) { if (xb_ld(&(bar)[XB_TMO])) break; if (_sp > XB_SPIN_CAP) { atomicAdd(&(bar)[XB_TMO], 1u); break; } } } } while (0)
struct XcdBarrier { unsigned* bar; unsigned x; volatile LAS unsigned* st; };
__device__ __forceinline__ void xcd_barrier_complete(unsigned* bar, unsigned x, unsigned& nloc, unsigned& nx) {
    const unsigned G = gridDim.x;
    unsigned sum, cnt, mine, sp = 0u;
    for (;;) {
        sum = 0u; cnt = 0u; mine = 0u;
#pragma unroll
        for (unsigned j = 0; j < 16; ++j) { const unsigned c = xb_ld(&bar[XB_XCNT(j)]); sum += c; cnt += (c > 0u) ? 1u : 0u; mine = (j == x) ? c : mine; }
        if (sum == G) break;
        __builtin_amdgcn_s_sleep(1);
        if ((++sp & 255u) == 0u) { if (xb_ld(&bar[XB_TMO])) break; if (sp > XB_SPIN_CAP) { atomicAdd(&bar[XB_TMO], 1u); break; } }
    }
    nloc = mine > 0u ? mine : 1u; nx = cnt > 0u ? cnt : 1u;
}
__device__ __forceinline__ void grid_barrier(const XcdBarrier& b) {
    asm volatile("s_waitcnt vmcnt(0)" ::: "memory");
    __syncthreads();
    if (threadIdx.x == 0) {
        unsigned* bar = b.bar;
        __builtin_amdgcn_s_waitcnt(0);
        unsigned nloc = b.st[0], nx = b.st[1];
        if (nloc == 0u) { xcd_barrier_complete(bar, b.x, nloc, nx); b.st[0] = nloc; b.st[1] = nx; }
        const unsigned old = xb_add(&bar[XB_XSUB(b.x)], 1u);
        const unsigned gen = old / nloc;
        if (old + 1u == (gen + 1u) * nloc) {
            __builtin_amdgcn_fence(__ATOMIC_RELEASE, "agent");
            asm volatile("s_waitcnt vmcnt(0)" ::: "memory");
            const unsigned og = xb_add(&bar[XB_TOP], 1u);
            const unsigned tg = og / nx;
            if (og + 1u == (tg + 1u) * nx) xb_add(&bar[XB_TOPGEN], 1u);
            else XB_SPIN(xb_ld(&bar[XB_TOPGEN]) == tg, bar);
            __builtin_amdgcn_fence(__ATOMIC_ACQUIRE, "agent");
            xb_add(&bar[XB_XGEN(b.x)], 1u);
            asm volatile("s_waitcnt vmcnt(0)" ::: "memory");
        } else {
            XB_SPIN(xb_ld(&bar[XB_XGEN(b.x)]) == gen, bar);
            __builtin_amdgcn_fence(__ATOMIC_ACQUIRE, "agent");
            asm volatile("s_waitcnt vmcnt(0)" ::: "memory");
        }
    }
    __syncthreads();
}

struct Unit { const unsigned char* A; const unsigned char* B; unsigned char* O; const unsigned char* X; const float* G; int ldo; int kind; float scale; };
constexpr int HTB = 128 * 64 * 2;
__device__ __forceinline__ int lds_byte(int r, int c) { const int st = (r >> 4) * 2 + (c >> 5), rr = r & 15, cc = c & 31, ob = rr * 64 + cc * 2; return st * 1024 + (ob ^ (((ob >> 9) & 1) << 5)); }
__device__ __forceinline__ void stage_rc(int b, int& R, int& C) { const int st = b / 1024, sb = b % 1024, swz = sb ^ (((sb >> 9) & 1) << 5); R = (st >> 1) * 16 + swz / 64; C = (st & 1) * 32 + (swz % 64) / 2; }
__device__ __forceinline__ int perm32(int rho) { const int n = rho >> 4, i = rho & 15; return 8 * (i >> 2) + 4 * n + (i & 3); }
__device__ __forceinline__ void tile_order(int L, int nM, int nN, int& pm, int& pn) {
    const int nwg = nM * nN; int wgid = L;
    { const int q = nwg / 8, r = nwg % 8, xcd = wgid % 8, off = wgid / 8; wgid = (xcd < r ? xcd * (q + 1) : r * (q + 1) + (xcd - r) * q) + off; }
    const int nig = 8 * nN, gid = wgid / nig, fm = gid * 8, gsz = (nM - fm) < 8 ? (nM - fm) : 8;
    pm = fm + ((wgid % nig) % gsz); pn = (wgid % nig) / gsz;
}

template <bool PERM, bool HALFM = false, class UF, class Epi>
__device__ __forceinline__ void gemm_phase(LAS unsigned char* lds, const int lda, const int ldb, const int nt, const int tseg, const long segoff, const long segoffB, const UF& uf, const Epi& E) {
    const int tid = otid(), wid = __builtin_amdgcn_readfirstlane(tid >> 6), lane = tid & 63, wr = wid >> 2, wc = wid & 3, fr = lane & 15, fq = lane >> 4;
    unsigned voffA[2], voffB[2];
#pragma unroll
    for (int i = 0; i < 2; ++i) { int R, C; stage_rc(tid * 16 + i * 8192, R, C); const int Rb = PERM ? ((R & ~31) + perm32(R & 31)) : R;
        voffA[i] = (unsigned)(R * lda + C * 2); voffB[i] = (unsigned)(Rb * ldb + C * 2); }
    const long kstep = 128;
    const long hstepA = 128L * lda, hstepB = 128L * ldb;
    const unsigned ldsw = (unsigned)wid * 1024u;
    const int aoff = lds_byte(wr * 64 + fr, fq * 8), boff = lds_byte(wc * 32 + fr, fq * 8);
#define PG8_SA(b, h) (((b) * 2 + (h)) * HTB)
#define PG8_SB(b, h) ((4 + (b) * 2 + (h)) * HTB)
#define PG8_STAGE(bufoff, gbase, voff) do { _Pragma("unroll") for (int _i = 0; _i < 2; ++_i) \
        __builtin_amdgcn_global_load_lds((const unsigned*)((const unsigned char*)(gbase) + (voff)[_i]), (LAS unsigned*)(lds + (bufoff) + ldsw + _i * 8192), 16, 0, 0); } while (0)
#define PG8_LDA(dst, b, h) do { if (HALFM && (h) == 1) break; _Pragma("unroll") for (int m = 0; m < 4; ++m) _Pragma("unroll") for (int k = 0; k < 2; ++k) dst[m][k] = *(const LAS bf16x8*)(lds + PG8_SA(b, h) + aoff + m * 2048 + k * 1024); } while (0)
#define PG8_LDB(dst, b, h) do { _Pragma("unroll") for (int n = 0; n < 2; ++n) _Pragma("unroll") for (int k = 0; k < 2; ++k) dst[n][k] = *(const LAS bf16x8*)(lds + PG8_SB(b, h) + boff + n * 2048 + k * 1024); } while (0)
#define PG8_MMA(ai, bj, At, Bt) do { if (HALFM && (ai) == 1) break; __builtin_amdgcn_s_setprio(1); _Pragma("unroll") for (int m = 0; m < 4; ++m) _Pragma("unroll") for (int n = 0; n < 2; ++n) _Pragma("unroll") for (int k = 0; k < 2; ++k) \
        acc[ai][bj][m][n] = __builtin_amdgcn_mfma_f32_16x16x32_bf16(Bt[n][k], At[m][k], acc[ai][bj][m][n], 0, 0, 0); __builtin_amdgcn_s_setprio(0); } while (0)
#define PG8_WAIT_V(n) asm volatile("s_waitcnt vmcnt(" #n ")" ::: "memory")
#define PG8_WAIT_L(n) asm volatile("s_waitcnt lgkmcnt(" #n ")" ::: "memory")
#define PG8_BAR __builtin_amdgcn_s_barrier()
#define PG8_SCHED __builtin_amdgcn_sched_barrier(0)
#define PG8_KA(base, t) ((base) + (long)(t) * kstep + ((t) >= tseg ? segoff : 0L))
#define PG8_KB(base, t) ((base) + (long)(t) * kstep + ((t) >= tseg ? segoffB : 0L))
    Unit cur, nxt; int ui = 0;
    if (!uf(0, cur)) return;
    f32x4 acc[2][2][4][2];
#pragma unroll
    for (int a = 0; a < 2; ++a)
#pragma unroll
        for (int b = 0; b < 2; ++b)
#pragma unroll
            for (int m = 0; m < 4; ++m)
#pragma unroll
                for (int n = 0; n < 2; ++n) acc[a][b][m][n] = (f32x4){0.f, 0.f, 0.f, 0.f};
    bf16x8 At[4][2], B0[2][2], B1[2][2];
    const unsigned char* cA = cur.A; const unsigned char* cB = cur.B;
    PG8_STAGE(PG8_SB(0, 0), cB, voffB); PG8_STAGE(PG8_SA(0, 0), cA, voffA); PG8_STAGE(PG8_SB(0, 1), cB + hstepB, voffB); PG8_STAGE(PG8_SA(0, 1), cA + hstepA, voffA);
    if (wr == 1) PG8_BAR;
    PG8_WAIT_V(4); PG8_BAR;
    PG8_STAGE(PG8_SB(1, 0), PG8_KB(cB, 1), voffB); PG8_STAGE(PG8_SA(1, 0), PG8_KA(cA, 1), voffA); PG8_STAGE(PG8_SB(1, 1), PG8_KB(cB, 1) + hstepB, voffB);
    PG8_WAIT_V(6); PG8_BAR;
    for (;;) {
        const bool has_next = uf(ui + 1, nxt);
        const unsigned char* nA = has_next ? nxt.A : cA; const unsigned char* nB = has_next ? nxt.B : cB;
        for (int t = 0; t < nt; t += 2) {
            const bool last = (t == nt - 2);
            const unsigned char* a1 = PG8_KA(cA, t + 1);
            const unsigned char* a2 = last ? nA : PG8_KA(cA, t + 2); const unsigned char* b2 = last ? nB : PG8_KB(cB, t + 2);
            const unsigned char* a3 = last ? PG8_KA(nA, 1) : PG8_KA(cA, t + 3); const unsigned char* b3 = last ? PG8_KB(nB, 1) : PG8_KB(cB, t + 3);
            PG8_LDB(B0, 0, 0); PG8_SCHED; PG8_LDA(At, 0, 0); PG8_STAGE(PG8_SA(1, 1), a1 + hstepA, voffA);
            PG8_WAIT_L(8); PG8_BAR; PG8_WAIT_L(0); PG8_MMA(0, 0, At, B0); PG8_BAR; PG8_SCHED;
            PG8_LDB(B1, 0, 1); PG8_STAGE(PG8_SB(0, 0), b2, voffB);
            PG8_BAR; PG8_WAIT_L(0); PG8_MMA(0, 1, At, B1); PG8_BAR;
            PG8_LDA(At, 0, 1); PG8_STAGE(PG8_SA(0, 0), a2, voffA);
            PG8_BAR; PG8_WAIT_L(0); PG8_MMA(1, 0, At, B0); PG8_BAR; PG8_SCHED;
            PG8_STAGE(PG8_SB(0, 1), b2 + hstepB, voffB);
            PG8_WAIT_V(6); PG8_BAR; PG8_MMA(1, 1, At, B1); PG8_BAR;
            PG8_LDB(B0, 1, 0); PG8_SCHED; PG8_LDA(At, 1, 0); PG8_STAGE(PG8_SA(0, 1), a2 + hstepA, voffA);
            PG8_WAIT_L(8); PG8_BAR; PG8_WAIT_L(0); PG8_MMA(0, 0, At, B0); PG8_BAR; PG8_SCHED;
            PG8_LDB(B1, 1, 1); PG8_STAGE(PG8_SB(1, 0), b3, voffB);
            PG8_BAR; PG8_WAIT_L(0); PG8_MMA(0, 1, At, B1); PG8_BAR;
            PG8_LDA(At, 1, 1); PG8_STAGE(PG8_SA(1, 0), a3, voffA);
            PG8_BAR; PG8_WAIT_L(0); PG8_MMA(1, 0, At, B0); PG8_BAR; PG8_SCHED;
            PG8_STAGE(PG8_SB(1, 1), b3 + hstepB, voffB);
            PG8_WAIT_V(6); PG8_BAR; PG8_MMA(1, 1, At, B1); PG8_BAR;
        }
        E(acc, cur, wr, wc, fr, fq);
        if (!has_next) break;
#pragma unroll
        for (int a = 0; a < 2; ++a)
#pragma unroll
            for (int b = 0; b < 2; ++b)
#pragma unroll
                for (int m = 0; m < 4; ++m)
#pragma unroll
                    for (int n = 0; n < 2; ++n) acc[a][b][m][n] = (f32x4){0.f, 0.f, 0.f, 0.f};
        cur = nxt; cA = nA; cB = nB; ++ui;
    }
    PG8_WAIT_V(0);
    if (wr == 0) PG8_BAR;
    PG8_BAR;
#undef PG8_SA
#undef PG8_SB
#undef PG8_STAGE
#undef PG8_LDA
#undef PG8_LDB
#undef PG8_MMA
#undef PG8_WAIT_V
#undef PG8_WAIT_L
#undef PG8_BAR
#undef PG8_SCHED
#undef PG8_KA
#undef PG8_KB
}

struct EpiBf16 {
    __device__ __forceinline__ void operator()(const f32x4 (&acc)[2][2][4][2], const Unit& u, int wr, int wc, int fr, int fq) const {
        if (u.kind == 1) {
            if (wc < 2) {
#pragma unroll
                for (int ai = 0; ai < 2; ++ai)
#pragma unroll
                    for (int m = 0; m < 4; ++m) { float* rowp = (float*)(u.O + (size_t)(ai * 128 + wr * 64 + m * 16 + fr) * u.ldo) + wc * 32 + 8 * fq;
                        *(f32x4*)(rowp) = acc[ai][0][m][0]; *(f32x4*)(rowp + 4) = acc[ai][0][m][1]; }
            }
            return;
        }
        const bool gate = (u.kind == 2);
#pragma unroll
        for (int ai = 0; ai < 2; ++ai)
#pragma unroll
            for (int m = 0; m < 4; ++m) {
                const size_t ro = (size_t)(ai * 128 + wr * 64 + m * 16 + fr) * u.ldo + (size_t)(wc * 32 + 8 * fq) * 2;
#pragma unroll
                for (int bj = 0; bj < 2; ++bj) { f32x4 v0 = acc[ai][bj][m][0], v1 = acc[ai][bj][m][1];
                    if (gate) { const u32x4 z = *(const u32x4*)(u.X + ro + bj * 256);
                        v0[0] *= u.scale * silu_f(bflo(z.x)); v0[1] *= u.scale * silu_f(bfhi(z.x)); v0[2] *= u.scale * silu_f(bflo(z.y)); v0[3] *= u.scale * silu_f(bfhi(z.y));
                        v1[0] *= u.scale * silu_f(bflo(z.z)); v1[1] *= u.scale * silu_f(bfhi(z.z)); v1[2] *= u.scale * silu_f(bflo(z.w)); v1[3] *= u.scale * silu_f(bfhi(z.w)); }
                    u32x4 w; w.x = cvt_pk(v0[0], v0[1]); w.y = cvt_pk(v0[2], v0[3]); w.z = cvt_pk(v1[0], v1[1]); w.w = cvt_pk(v1[2], v1[3]);
                    *(u32x4*)(u.O + ro + bj * 256) = w; }
            }
    }
};
template <bool HALF> struct EpiResT {
    __device__ __forceinline__ void operator()(const f32x4 (&acc)[2][2][4][2], const Unit& u, int wr, int wc, int fr, int fq) const {
        f32x4 gv[2][2];
#pragma unroll
        for (int bj = 0; bj < 2; ++bj)
#pragma unroll
            for (int n = 0; n < 2; ++n) gv[bj][n] = *(const f32x4*)(u.G + bj * 128 + wc * 32 + n * 16 + 4 * fq);
#pragma unroll
        for (int ai = 0; ai < (HALF ? 1 : 2); ++ai)
#pragma unroll
            for (int m = 0; m < 4; ++m) {
                const size_t ro = (size_t)(ai * 128 + wr * 64 + m * 16 + fr) * 4096 + (size_t)(wc * 32 + 4 * fq) * 4;
#pragma unroll
                for (int bj = 0; bj < 2; ++bj)
#pragma unroll
                    for (int n = 0; n < 2; ++n) { const size_t o = ro + (size_t)(bj * 128 + n * 16) * 4;
                        const f32x4 xo = *(const f32x4*)(u.X + o); *(f32x4*)(u.O + o) = xo + gv[bj][n] * acc[ai][bj][m][n]; }
            }
    }
};

typedef EpiResT<false> EpiRes;
__device__ void phase_prep0(const P& p, unsigned char* sm) {
    const int tid = otid(), G = gridDim.x, bid = blockIdx.x;
    float* sact = (float*)sm; float* red = sact + 9 * 1024;
    for (int i = tid; i < 9 * 1024; i += 512) { const int ci = i >> 10, k = i & 1023; const float v = ci == 0 ? p.c_ctx[k] : p.c[(ci - 1) * 1024 + k]; sact[i] = silu_f(v); }
    __syncthreads();
    float* MOD = (float*)(p.ws + WS_MOD);
    for (int u = bid; u < 192; u += G) {
        const int layer = u / 48, cb = u % 48, kq = tid >> 6, cl = tid & 63, col = cb * 64 + cl;
        float a0 = 0, a1 = 0, a2 = 0, a3 = 0, a4 = 0, a5 = 0, a6 = 0, a7 = 0, a8 = 0;
        const float* w = p.w_mod + ((size_t)layer * 1024 + kq * 128) * 3072 + col; const float* sa = sact + kq * 128;
#pragma unroll 16
        for (int k = 0; k < 128; ++k) { const float wv = w[(size_t)k * 3072];
            a0 += sa[k] * wv; a1 += sa[1024 + k] * wv; a2 += sa[2048 + k] * wv; a3 += sa[3072 + k] * wv; a4 += sa[4096 + k] * wv;
            a5 += sa[5120 + k] * wv; a6 += sa[6144 + k] * wv; a7 += sa[7168 + k] * wv; a8 += sa[8192 + k] * wv; }
        float* rr = red + kq * 576 + cl;
        rr[0] = a0; rr[64] = a1; rr[128] = a2; rr[192] = a3; rr[256] = a4; rr[320] = a5; rr[384] = a6; rr[448] = a7; rr[512] = a8;
        __syncthreads();
        for (int o = tid; o < 576; o += 512) { const int ci = o >> 6, c2 = cb * 64 + (o & 63); float s = 0;
            for (int q = 0; q < 8; ++q) s += red[q * 576 + o];
            MOD[(ci * 4 + layer) * 3072 + c2] = s + p.b_mod[layer * 3072 + c2]; }
        __syncthreads();
    }
    const long gt = (long)bid * 512 + tid, gn = (long)G * 512;
    const float TWO_PI = 6.283185307179586f;
    for (long i = gt; i < 512 * 256 / 8; i += gn) { const int j = (int)(i >> 5), c0 = (int)(i & 31) * 8, m = j >> 1, part = j & 1; float v[8];
#pragma unroll
        for (int e = 0; e < 8; ++e) { const float ang = (float)((m * (c0 + e)) & 255) * (TWO_PI / 256.f); v[e] = j == 1 ? (((c0 + e) & 1) ? -1.f : 1.f) : (part ? -__sinf(ang) : __cosf(ang)); }
        u32x4 w; w.x = cvt_pk(v[0], v[1]); w.y = cvt_pk(v[2], v[3]); w.z = cvt_pk(v[4], v[5]); w.w = cvt_pk(v[6], v[7]);
        *(u32x4*)(p.ws + WS_TC + (size_t)i * 16) = w; }
    for (long i = gt; i < 256 * 512 / 8; i += gn) { const int k = (int)(i >> 6), kk0 = (int)(i & 63) * 8, part = kk0 >> 8, l0 = kk0 & 255; float v[8];
#pragma unroll
        for (int e = 0; e < 8; ++e) { const float ang = (float)((k * (l0 + e)) & 255) * (TWO_PI / 256.f); v[e] = part ? __sinf(ang) : __cosf(ang); }
        u32x4 w; w.x = cvt_pk(v[0], v[1]); w.y = cvt_pk(v[2], v[3]); w.z = cvt_pk(v[4], v[5]); w.w = cvt_pk(v[6], v[7]);
        *(u32x4*)(p.ws + WS_ALC + (size_t)i * 16) = w; }
    for (long i = gt; i < 2048L * 2048 / 8; i += gn) { const int k = (int)(i >> 8), kk0 = (int)(i & 255) * 8, part = kk0 >> 10, l0 = kk0 & 1023; float v[8];
#pragma unroll
        for (int e = 0; e < 8; ++e) { const int l = l0 + e; const float ang = (float)((k * l) & 2047) * (TWO_PI / 2048.f);
            v[e] = part ? (l == 0 ? ((k & 1) ? -1.f : 1.f) : __sinf(ang)) : __cosf(ang); }
        u32x4 w; w.x = cvt_pk(v[0], v[1]); w.y = cvt_pk(v[2], v[3]); w.z = cvt_pk(v[4], v[5]); w.w = cvt_pk(v[6], v[7]);
        *(u32x4*)(slot_ptr(p, k >> 9, 1) + ((size_t)(k & 511) * 2048 + kk0) * 2) = w; }
    for (long i = gt; i < 2L * 1024 * 1024 / 8; i += gn) { const int e = (int)(i >> 17), d = (int)(i >> 7) & 1023, c0 = (int)(i & 127) * 8;
        const float* src = p.fc_w_in + ((size_t)e * 1024 + d) * 6144 + c0; const f32x4 x0 = *(const f32x4*)src, x1 = *(const f32x4*)(src + 4);
        u32x4 w; w.x = cvt_pk(x0[0], x0[1]); w.y = cvt_pk(x0[2], x0[3]); w.z = cvt_pk(x1[0], x1[1]); w.w = cvt_pk(x1[2], x1[3]);
        *(u32x4*)(p.ws + WS_WUBF + (size_t)i * 16) = w; }
}

struct UF_Prep1 { unsigned char* ws; int G, c;
    __device__ __forceinline__ bool operator()(int i, Unit& u) const { const int L = i * G + c; if (L >= 64) return false;
        const int e = L >> 5, g = (L >> 3) & 3, pm = (L >> 2) & 1, pn = L & 3;
        u.A = ws + WS_TC + (size_t)pm * 256 * 512; u.B = ws + WS_WUBF + (((size_t)e * 1024 + pn * 256) * 1024 + g * 256) * 2;
        u.O = ws + WS_WF + (((size_t)e * 2048 + g * 512 + pm * 256) * 1024 + pn * 256) * 2; u.ldo = 2048; u.kind = 0; u.X = nullptr; u.G = nullptr; u.scale = 1.f; return true; } };

template <class RowPtr>
__device__ __forceinline__ void conv_tiles4(const float* W, int ldw, int k0, int n0, int nvalid  , const RowPtr& rowptr, float* sT) {
    const int tid = otid();
#pragma unroll
    for (int j = 0; j < 4; ++j)
#pragma unroll
        for (int i = 0; i < 8; ++i) { const int e = tid + i * 512, kk = e >> 6, nn = e & 63, n = n0 + j * 64 + nn;
            sT[j * 4160 + kk * 65 + nn] = n < nvalid ? W[(size_t)(k0 + kk) * ldw + n] : 0.f; }
    __syncthreads();
    { const int nn = tid >> 3, kc = (tid & 7) * 8;
#pragma unroll
      for (int j = 0; j < 4; ++j) { float v[8];
#pragma unroll
          for (int i = 0; i < 8; ++i) v[i] = sT[j * 4160 + (kc + i) * 65 + nn];
          u32x4 w; w.x = cvt_pk(v[0], v[1]); w.y = cvt_pk(v[2], v[3]); w.z = cvt_pk(v[4], v[5]); w.w = cvt_pk(v[6], v[7]);
          *(u32x4*)(rowptr(n0 + j * 64 + nn) + (size_t)(k0 + kc) * 2) = w; } }
    __syncthreads();
}

__device__ void norm_rows(const P& p, int layer, int tok_lo, int ntok, unsigned char* hm) {
    const int tid = otid(), lane = tid & 63, gw = blockIdx.x * 8 + (tid >> 6), nw = gridDim.x * 8;
    const float* MOD = (const float*)(p.ws + WS_MOD);
    const float* ng = p.norm_g + layer * 1024;
    const int rpw = (ntok + nw - 1) / nw, r_lo = gw * rpw, r_hi = r_lo + rpw < ntok ? r_lo + rpw : ntok;
    f32x4 gs[4], shv[4]; int cur_cond = -1;
#pragma unroll
    for (int i = 0; i < 4; ++i) { gs[i] = (f32x4){0.f, 0.f, 0.f, 0.f}; shv[i] = gs[i]; }
    for (int t0 = r_lo; t0 < r_hi; t0 += 4) {
        f32x4 v[4][4]; float ss[4];
#pragma unroll
        for (int j = 0; j < 4; ++j) { const int t = t0 + j < r_hi ? t0 + j : r_hi - 1, tok = tok_lo + t;
            const float* xr = layer == 0 ? (tok < TOKC ? p.x_prompt + (size_t)tok * 1024 : p.x_sample + (size_t)(tok - TOKC) * 1024) : p.out + (size_t)tok * 1024;
#pragma unroll
            for (int i = 0; i < 4; ++i) v[j][i] = *(const f32x4*)(xr + i * 256 + lane * 4); }
#pragma unroll
        for (int j = 0; j < 4; ++j) { float a = 0.f;
#pragma unroll
            for (int i = 0; i < 4; ++i) a += v[j][i][0] * v[j][i][0] + v[j][i][1] * v[j][i][1] + v[j][i][2] * v[j][i][2] + v[j][i][3] * v[j][i][3];
            ss[j] = a; }
#pragma unroll
        for (int o = 32; o >= 1; o >>= 1) {
#pragma unroll
            for (int j = 0; j < 4; ++j) ss[j] += __shfl_xor(ss[j], o); }
#pragma unroll
        for (int j = 0; j < 4; ++j) if (t0 + j < r_hi) { const int t = t0 + j, tok = tok_lo + t;
            const float rstd = rsqrtf(ss[j] * (1.0f / 1024.f) + 1e-6f);
            const int cond = cond_of_tok(tok);
            if (cond != cur_cond) { cur_cond = cond; const float* md = MOD + (size_t)(cond * 4 + layer) * 3072;
#pragma unroll
                for (int i = 0; i < 4; ++i) { const int col = i * 256 + lane * 4; const f32x4 g = *(const f32x4*)(ng + col), sc = *(const f32x4*)(md + 1024 + col);
                    shv[i] = *(const f32x4*)(md + col);
#pragma unroll
                    for (int e = 0; e < 4; ++e) gs[i][e] = g[e] * (1.0f + sc[e]); } }
#pragma unroll
            for (int i = 0; i < 4; ++i) { const int col = i * 256 + lane * 4; f32x4 y;
#pragma unroll
                for (int e = 0; e < 4; ++e) y[e] = (v[j][i][e] * rstd) * gs[i][e] + shv[i][e];
                u32x2 w; w.x = cvt_pk(y[0], y[1]); w.y = cvt_pk(y[2], y[3]);
                *(u32x2*)(hm + ((size_t)t * 1024 + col) * 2) = w; } }
    }
}

__device__ void conv_even(const P& p, unsigned char* sm, int layer, int rank, int nblk) {
    const int e = layer >> 1;
    {
        float* sT = (float*)sm;
        const P* pp = &p;
        for (int t = rank; t < 320 + 128; t += nblk) {
            if (t < 320) { const int kt = t & 15, n0 = (t >> 4) * 256;
                conv_tiles4(p.fc_w_in + (size_t)e * 1024 * 6144 + 1024, 6144, kt * 64, n0, 5120, [pp](int n) { return slot_ptr(*pp, 8 + (n >> 10), 1) + (size_t)(n & 1023) * 2048; }, sT);
            } else { const int t2 = t - 320, kt = t2 & 31, n0 = (t2 >> 5) * 256;
                conv_tiles4(p.fc_w_out + (size_t)e * 2048 * 1024, 1024, kt * 64, n0, 1024, [pp](int n) { return slot_ptr(*pp, 13 + (n >> 9), 1) + (size_t)(n & 511) * 4096; }, sT); }
        }
    }
}
__device__ void phase_normE(const P& p, unsigned char* sm, int layer, int pass) {
    if (pass == 0 && layer == 0) conv_even(p, sm, layer, blockIdx.x, gridDim.x);
    norm_rows(p, layer, pass ? E_T0 * 256 : 0, (pass ? E_T1 : E_T0) * 256, p.ws + E_HM);
}
struct UF_G1E { const P* p; int e, pass, G, c;
    __device__ __forceinline__ bool operator()(int i, Unit& u) const { int L = i * G + c; const int nt = pass ? E_T1 : E_T0, t0 = pass ? E_T0 : 0; if (L >= nt * 24) return false;
        unsigned char* ws = p->ws; int pm, pn; u.kind = 0; u.X = nullptr; u.G = nullptr; u.scale = 1.f;
        if (L < nt * 20) { tile_order(L, nt, 20, pm, pn);
            u.A = ws + E_HM + (size_t)pm * 256 * 2048; u.B = slot_ptr(*p, 8 + (pn >> 2), 1) + (size_t)(pn & 3) * 256 * 2048; u.ldo = 2048;
            if (pn < 4) u.O = ws + E_ZA + (((size_t)(t0 + pm) * 256) * 1024 + pn * 256) * 2;
            else u.O = ws + E_PL + (size_t)((pn - 4) >> 2) * E_PS + ((size_t)pm * 256 * 1024 + (pn & 3) * 256) * 2;
        } else { L -= nt * 20; tile_order(L, 4, nt, pm, pn);
            u.A = ws + WS_WF + ((size_t)e * 2048 + pm * 512) * 2048; u.B = ws + E_HM + (size_t)pn * 256 * 2048;
            const int g = pm, j0 = 0, tg = t0 + pn;
            if (tg < 16) { u.O = ws + E_VTC + (((size_t)(tg * 4 + g) * 512 + j0) * 256) * 2; u.ldo = 512; }
            else { const int t2 = tg - 16, b = t2 >> 3, l0 = (t2 & 7) * 256; u.O = ws + E_VTL + (((size_t)(b * 4 + g) * 512 + j0) * 2048 + l0) * 2; u.ldo = 4096; }
        }
        return true; } };
__device__ __forceinline__ void up8(const u32x4 a, const u32x4 b, float (&o)[8]) {
    o[0] = bflo(a.x) * bflo(b.x); o[1] = bfhi(a.x) * bfhi(b.x); o[2] = bflo(a.y) * bflo(b.y); o[3] = bfhi(a.y) * bfhi(b.y);
    o[4] = bflo(a.z) * bflo(b.z); o[5] = bfhi(a.z) * bfhi(b.z); o[6] = bflo(a.w) * bflo(b.w); o[7] = bfhi(a.w) * bfhi(b.w); }
__device__ void phase_e3(const P& p, int layer, int pass) {
    const int e = layer >> 1;
    const long gt = (long)blockIdx.x * 512 + otid(), gn = (long)gridDim.x * 512;
    const unsigned char* PL = p.ws + E_PL; const size_t PS = E_PS; const int tok_lo = pass ? E_T0 * 256 : 0, nstrip = (pass ? E_T1 : E_T0) * 64;
    const float* cw = p.fc_conv_w + (size_t)e * 3 * 1024;
    for (long it = gt; it < (long)nstrip * 128; it += gn) {
        const int tl = (int)(it >> 7) * 4, c8 = (int)(it & 127) * 8, tok = tok_lo + tl;
        const int rl = tok < TOKC ? 256 : 64, pos = tok & (rl - 1);
        const size_t o = ((size_t)tl * 1024 + c8) * 2;
        float cv[6][8];
        const u32x4 zero = {0, 0, 0, 0};
#pragma unroll
        for (int j = 0; j < 6; ++j) { const bool ok = (j == 0) ? (pos > 0) : (j == 5 ? (pos + 4 < rl) : true);
            const u32x4 cc = ok ? *(const u32x4*)(PL + PS + o + (long)(j - 1) * 2048) : zero, vv = ok ? *(const u32x4*)(PL + 2 * PS + o + (long)(j - 1) * 2048) : zero;
            up8(cc, vv, cv[j]); }
        float w0[8], w1[8], w2[8];
        { const f32x4 a0 = *(const f32x4*)(cw + c8), a1 = *(const f32x4*)(cw + c8 + 4), b0 = *(const f32x4*)(cw + 1024 + c8), b1 = *(const f32x4*)(cw + 1024 + c8 + 4),
                      c0 = *(const f32x4*)(cw + 2048 + c8), c1 = *(const f32x4*)(cw + 2048 + c8 + 4);
#pragma unroll
          for (int j = 0; j < 4; ++j) { w0[j] = a0[j]; w0[4 + j] = a1[j]; w1[j] = b0[j]; w1[4 + j] = b1[j]; w2[j] = c0[j]; w2[4 + j] = c1[j]; } }
#pragma unroll
        for (int t = 0; t < 4; ++t) {
            const u32x4 bv = *(const u32x4*)(PL + o + (size_t)t * 2048), zv = *(const u32x4*)(PL + 3 * PS + o + (size_t)t * 2048);
            float bz[8];
            bz[0] = bflo(bv.x) * silu_f(bflo(zv.x)); bz[1] = bfhi(bv.x) * silu_f(bfhi(zv.x)); bz[2] = bflo(bv.y) * silu_f(bflo(zv.y)); bz[3] = bfhi(bv.y) * silu_f(bfhi(zv.y));
            bz[4] = bflo(bv.z) * silu_f(bflo(zv.z)); bz[5] = bfhi(bv.z) * silu_f(bfhi(zv.z)); bz[6] = bflo(bv.w) * silu_f(bflo(zv.w)); bz[7] = bfhi(bv.w) * silu_f(bfhi(zv.w));
            float r[8];
#pragma unroll
            for (int j = 0; j < 8; ++j) r[j] = bz[j] * (w0[j] * cv[t][j] + w1[j] * cv[t + 1][j] + w2[j] * cv[t + 2][j]);
            u32x4 w; w.x = cvt_pk(r[0], r[1]); w.y = cvt_pk(r[2], r[3]); w.z = cvt_pk(r[4], r[5]); w.w = cvt_pk(r[6], r[7]);
            *(u32x4*)(p.ws + E_YB + ((size_t)(tok + t) * 1024 + c8) * 2) = w;
        }
    }
    if (pass == 1) {
        unsigned short* VT = (unsigned short*)(p.ws + E_VTL);
        for (long it = gt; it < 32L * 128 * 128; it += gn) {
            const int l0 = (int)(it & 127) * 8, m = (int)(it >> 7) & 127; const long slice = it >> 14;
            unsigned short* base = VT + (size_t)slice * 512 * 2048;
            unsigned short* vr = base + (size_t)(2 * m) * 2048; unsigned short* vi = vr + 2048;
            const u32x4 a = *(const u32x4*)(vr + l0), b = *(const u32x4*)(vi + l0);
            const u32x4 ma = *(const u32x4*)(vr + 2040 - l0), mb = *(const u32x4*)(vi + 2040 - l0);
            float x0r, x0i;
            if (l0 == 0) { x0r = 0.f; x0i = 0.f; } else { x0r = bf2f((short)vr[2048 - l0]); x0i = bf2f((short)vi[2048 - l0]); }
            const float ny_r = bf2f((short)vr[1024]), ny_i = bf2f((short)vi[1024]);
            float er[8], eo[8];
            float es[8];
            er[0] = bflo(a.x) + x0r;        eo[0] = bflo(b.x) - x0i;        es[0] = bflo(b.x) + x0i;
            er[1] = bfhi(a.x) + bfhi(ma.w); eo[1] = bfhi(b.x) - bfhi(mb.w); es[1] = bfhi(b.x) + bfhi(mb.w);
            er[2] = bflo(a.y) + bflo(ma.w); eo[2] = bflo(b.y) - bflo(mb.w); es[2] = bflo(b.y) + bflo(mb.w);
            er[3] = bfhi(a.y) + bfhi(ma.z); eo[3] = bfhi(b.y) - bfhi(mb.z); es[3] = bfhi(b.y) + bfhi(mb.z);
            er[4] = bflo(a.z) + bflo(ma.z); eo[4] = bflo(b.z) - bflo(mb.z); es[4] = bflo(b.z) + bflo(mb.z);
            er[5] = bfhi(a.z) + bfhi(ma.y); eo[5] = bfhi(b.z) - bfhi(mb.y); es[5] = bfhi(b.z) + bfhi(mb.y);
            er[6] = bflo(a.w) + bflo(ma.y); eo[6] = bflo(b.w) - bflo(mb.y); es[6] = bflo(b.w) + bflo(mb.y);
            er[7] = bfhi(a.w) + bfhi(ma.x); eo[7] = bfhi(b.w) - bfhi(mb.x); es[7] = bfhi(b.w) + bfhi(mb.x);
            u32x4 w; w.x = cvt_pk(er[0], er[1]); w.y = cvt_pk(er[2], er[3]); w.z = cvt_pk(er[4], er[5]); w.w = cvt_pk(er[6], er[7]);
            if (m != 0) {
                if (l0 == 0) eo[0] = ny_r;
                u32x4 z; z.x = cvt_pk(eo[0], eo[1]); z.y = cvt_pk(eo[2], eo[3]); z.z = cvt_pk(eo[4], eo[5]); z.w = cvt_pk(eo[6], eo[7]);
                u32x4 zn; zn.x = cvt_pk(l0 == 0 ? ny_r : -eo[0], -eo[1]); zn.y = cvt_pk(-eo[2], -eo[3]); zn.z = cvt_pk(-eo[4], -eo[5]); zn.w = cvt_pk(-eo[6], -eo[7]);
                *(u32x4*)(vr + l0) = w; *(u32x4*)(vi + l0) = z;
                unsigned short* wr = base + (size_t)(2 * (256 - m)) * 2048;
                *(u32x4*)(wr + l0) = w; *(u32x4*)(wr + 2048 + l0) = zn;
            } else {
                u32x4 z0 = {0u, 0u, 0u, 0u}, z128 = {0u, 0u, 0u, 0u};
                if (l0 == 0) { z0.x = cvt_pk(ny_r, 0.f); z128.x = cvt_pk(ny_i, 0.f); es[0] = bflo(b.x); }
                u32x4 w128; w128.x = cvt_pk(es[0], es[1]); w128.y = cvt_pk(es[2], es[3]); w128.z = cvt_pk(es[4], es[5]); w128.w = cvt_pk(es[6], es[7]);
                *(u32x4*)(vr + l0) = w; *(u32x4*)(vi + l0) = z0;
                unsigned short* wr = base + (size_t)256 * 2048;
                *(u32x4*)(wr + l0) = w128; *(u32x4*)(wr + 2048 + l0) = z128;
            }
        }
        unsigned short* VC = (unsigned short*)(p.ws + E_VTC);
        for (long it = gt; it < 64L * 128 * 32; it += gn) {
            const int l0 = (int)(it & 31) * 8, m = (int)(it >> 5) & 127; const long slice = it >> 12;
            unsigned short* base = VC + (size_t)slice * 512 * 256;
            const u32x4 a = *(const u32x4*)(base + (size_t)(2 * m) * 256 + l0), b = *(const u32x4*)(base + (size_t)(2 * m + 1) * 256 + l0);
            if (m != 0) { u32x4 bn; bn.x = b.x ^ 0x80008000u; bn.y = b.y ^ 0x80008000u; bn.z = b.z ^ 0x80008000u; bn.w = b.w ^ 0x80008000u;
                unsigned short* wr = base + (size_t)(2 * (256 - m)) * 256; *(u32x4*)(wr + l0) = a; *(u32x4*)(wr + 256 + l0) = bn;
            } else { const u32x4 z = {0u, 0u, 0u, 0u};
                unsigned short* wr = base + (size_t)256 * 256; *(u32x4*)(wr + l0) = b; *(u32x4*)(wr + 256 + l0) = z; *(u32x4*)(base + 256 + l0) = z; }
        }
    }
}
struct UF_E4L { const P* p; int G, c;
    __device__ __forceinline__ bool operator()(int i, Unit& u) const { const int L = i * G + c; if (L >= 256) return false;
        const int xcd = L & 7, j = L >> 3, sl = xcd + 8 * (j >> 3), pm = j & 7, g = sl & 3, b = sl >> 2; unsigned char* ws = p->ws;
        u.A = slot_ptr(*p, pm >> 1, 1) + (size_t)(pm & 1) * 256 * 4096; u.B = ws + E_VTL + (size_t)(b * 4 + g) * 512 * 2048 * 2;
        const size_t o = (((size_t)TOKC + b * 2048 + pm * 256) * 1024 + g * 256) * 2;
        u.O = ws + E_YA + o; u.X = ws + E_ZA + o; u.ldo = 2048; u.kind = 2; u.G = nullptr; u.scale = 0.0013810679320049757f; return true; } };
struct UF_E4C { const P* p; int G, c;
    __device__ __forceinline__ bool operator()(int i, Unit& u) const { const int L = i * G + c; if (L >= 64) return false;
        const int g = L & 3, b = L >> 2; unsigned char* ws = p->ws;
        u.A = ws + WS_ALC; u.B = ws + E_VTC + (size_t)(b * 4 + g) * 512 * 256 * 2;
        const size_t o = (((size_t)b * 256) * 1024 + g * 256) * 2;
        u.O = ws + E_YA + o; u.X = ws + E_ZA + o; u.ldo = 2048; u.kind = 2; u.G = nullptr; u.scale = 0.00390625f; return true; } };
struct UF_G2 { const P* p; int layer, sub, G, c;
    __device__ __forceinline__ bool operator()(int i, Unit& u) const { const int L = i * G + c; int pm, pn, row0;
        if (sub == 0) { if (L >= 256) return false; tile_order(L, 64, 4, pm, pn); row0 = pm * 256; }
        else { if (L >= 128) return false; tile_order(L, 32, 4, pm, pn); row0 = 16384 + pm * 128; }
        unsigned char* ws = p->ws; const bool even = (layer & 1) == 0;
        if (even) { u.A = ws + E_YA + (size_t)row0 * 2048; u.B = slot_ptr(*p, 13 + (pn >> 1), 1) + (size_t)(pn & 1) * 256 * 4096; }
        else { u.A = ws + O_YN + (size_t)row0 * 4096; u.B = ws + O_WOUT + (size_t)pn * 256 * 4096; }
        const size_t o = ((size_t)row0 * 1024 + pn * 256);
        u.O = (unsigned char*)(p->out + o);
        u.X = layer == 0 ? (const unsigned char*)((row0 < TOKC ? p->x_prompt + (size_t)row0 * 1024 : p->x_sample + (size_t)(row0 - TOKC) * 1024) + pn * 256) : (const unsigned char*)(p->out + o);
        u.G = (const float*)(ws + WS_MOD) + (size_t)(cond_of_tok(row0) * 4 + layer) * 3072 + 2048 + pn * 256;
        u.ldo = 4096; u.kind = 0; u.scale = 1.f; return true; } };

__device__ void conv_odd(const P& p, unsigned char* sm, int layer, int rank, int nblk) {
    const int li = layer >> 1; float* sT = (float*)sm; unsigned char* ws = p.ws;
    for (int t = rank; t < 400 + 128; t += nblk) {
        if (t < 400) { const int kt = t & 15, n0 = (t >> 4) * 256;
            conv_tiles4(p.ssd_w_in + (size_t)li * 1024 * 6208, 6208, kt * 64, n0, 6208, [ws](int n) { return ws + O_WIN + (size_t)n * 2048; }, sT);
        } else { const int t2 = t - 400, kt = t2 & 31, n0 = (t2 >> 5) * 256;
            conv_tiles4(p.ssd_w_out + (size_t)li * 2048 * 1024, 1024, kt * 64, n0, 1024, [ws](int n) { return ws + O_WOUT + (size_t)n * 4096; }, sT); }
    }
}
__device__ void phase_normO(const P& p, unsigned char* sm, int layer) {
    norm_rows(p, layer, 0, TOK, p.ws + O_HM);
}
struct UF_G1O { unsigned char* ws; int pass, nq, G, c;
    __device__ __forceinline__ bool operator()(int i, Unit& u) const { const int L = i * G + c; if (L >= 80 * nq) return false;
        int pm, q; tile_order(L, 80, nq, pm, q); u.kind = 0; u.X = nullptr; u.G = nullptr; u.scale = 1.f;
        u.A = ws + O_HM + (size_t)pm * 256 * 2048;
        int nrow;
        if (q < 2) { nrow = 512 * pass + 256 * q; u.O = ws + O_Z + ((size_t)pm * 256 * 512 + q * 256) * 2; u.ldo = 1024; }
        else if (q < 4) { nrow = 2048 + 512 * pass + 256 * (q - 2); u.O = ws + O_RAWX + ((size_t)pm * 256 * 512 + (q - 2) * 256) * 2; u.ldo = 1024; }
        else if (q == 4) { nrow = 4096 + 256 * pass; u.O = ws + O_RAWB + (size_t)pm * 256 * 256 * 2; u.ldo = 512; }
        else if (q == 5) { nrow = 5120 + 256 * pass; u.O = ws + O_RAWC + (size_t)pm * 256 * 256 * 2; u.ldo = 512; }
        else { nrow = 6144; u.O = ws + O_DTR + (size_t)pm * 256 * 64 * 4; u.ldo = 256; u.kind = 1; }
        u.B = ws + O_WIN + (size_t)nrow * 2048; return true; } };

struct O3Tile { const unsigned char* src; unsigned char* dstN; unsigned char* dstT; int lds_, cch, ch0, ldn; };
__device__ __forceinline__ O3Tile o3_decode(unsigned char* ws, int ct, int pass) {
    O3Tile t; t.dstN = nullptr; t.dstT = nullptr; t.ldn = 512;
    if (ct < 8) { t.ch0 = ct * 64; t.src = ws + O_RAWX; t.lds_ = 1024; t.cch = 512 * pass + t.ch0; t.dstN = ws + O_XT; t.ldn = 1024; }
    else if (ct < 12) { t.ch0 = (ct - 8) * 64; t.src = ws + O_RAWB; t.lds_ = 512; t.cch = 2048 + 256 * pass + t.ch0; t.dstN = ws + O_BS; }
    else { t.ch0 = (ct - 12) * 64; t.src = ws + O_RAWC; t.lds_ = 512; t.cch = 3072 + 256 * pass + t.ch0; t.dstN = ws + O_CS; }
    return t;
}
__device__ __forceinline__ void o3_load(const O3Tile& t, int tok, int c8, u32x4& x0, u32x4& xm, u32x4& xp) {
    const int L = tok < TOKC ? 256 : 2048, pos = tok < TOKC ? (tok & 255) : ((tok - TOKC) & 2047);
    const unsigned char* sp = t.src + (size_t)tok * t.lds_ + (size_t)(t.ch0 + c8) * 2;
    x0 = *(const u32x4*)sp; xm = (u32x4){0, 0, 0, 0}; xp = (u32x4){0, 0, 0, 0};
    if (pos > 0) xm = *(const u32x4*)(sp - t.lds_);
    if (pos < L - 1) xp = *(const u32x4*)(sp + t.lds_);
}
__device__ void phase_o3(const P& p, unsigned char* sm, int layer, int pass) {
    const int li = layer >> 1, tid = otid();
    unsigned short* sT = (unsigned short*)sm;
    const float* cw = p.ssd_conv_w + (size_t)li * 3 * 4096; const float* cb = p.ssd_conv_b + (size_t)li * 4096;
    const int tl = tid >> 3, c8 = (tid & 7) * 8;
    int t = blockIdx.x; if (t >= 5120) return;
    int cur_ct = -1; f32x4 w0a, w0b, w1a, w1b, w2a, w2b, ba, bb; O3Tile T;
    u32x4 x0, xm, xp;
    { const O3Tile T0 = o3_decode(p.ws, t & 15, pass); o3_load(T0, (t >> 4) * 64 + tl, c8, x0, xm, xp); }
    for (; t < 5120; t += gridDim.x) {
        const int tt = t >> 4, ct = t & 15, tok = tt * 64 + tl;
        if (ct != cur_ct) { cur_ct = ct; T = o3_decode(p.ws, ct, pass); const int cc = T.cch + c8;
            w0a = *(const f32x4*)(cw + cc); w0b = *(const f32x4*)(cw + cc + 4); w1a = *(const f32x4*)(cw + 4096 + cc); w1b = *(const f32x4*)(cw + 4096 + cc + 4);
            w2a = *(const f32x4*)(cw + 8192 + cc); w2b = *(const f32x4*)(cw + 8192 + cc + 4); ba = *(const f32x4*)(cb + cc); bb = *(const f32x4*)(cb + cc + 4); }
        u32x4 n0 = x0, nm = xm, np = xp;
        { const int tn = t + gridDim.x; if (tn < 5120) { const O3Tile TN = o3_decode(p.ws, tn & 15, pass); o3_load(TN, (tn >> 4) * 64 + tl, c8, n0, nm, np); } }
        float r[8];
        r[0] = silu_f(w0a[0] * bflo(xm.x) + w1a[0] * bflo(x0.x) + w2a[0] * bflo(xp.x) + ba[0]);
        r[1] = silu_f(w0a[1] * bfhi(xm.x) + w1a[1] * bfhi(x0.x) + w2a[1] * bfhi(xp.x) + ba[1]);
        r[2] = silu_f(w0a[2] * bflo(xm.y) + w1a[2] * bflo(x0.y) + w2a[2] * bflo(xp.y) + ba[2]);
        r[3] = silu_f(w0a[3] * bfhi(xm.y) + w1a[3] * bfhi(x0.y) + w2a[3] * bfhi(xp.y) + ba[3]);
        r[4] = silu_f(w0b[0] * bflo(xm.z) + w1b[0] * bflo(x0.z) + w2b[0] * bflo(xp.z) + bb[0]);
        r[5] = silu_f(w0b[1] * bfhi(xm.z) + w1b[1] * bfhi(x0.z) + w2b[1] * bfhi(xp.z) + bb[1]);
        r[6] = silu_f(w0b[2] * bflo(xm.w) + w1b[2] * bflo(x0.w) + w2b[2] * bflo(xp.w) + bb[2]);
        r[7] = silu_f(w0b[3] * bfhi(xm.w) + w1b[3] * bfhi(x0.w) + w2b[3] * bfhi(xp.w) + bb[3]);
        u32x4 w; w.x = cvt_pk(r[0], r[1]); w.y = cvt_pk(r[2], r[3]); w.z = cvt_pk(r[4], r[5]); w.w = cvt_pk(r[6], r[7]);
        if (T.dstN) *(u32x4*)(T.dstN + (size_t)tok * T.ldn + (size_t)(T.ch0 + c8) * 2) = w;
        if (T.dstT) {
            unsigned* s32 = (unsigned*)(sT + tl * 66 + c8);
            s32[0] = w.x; s32[1] = w.y; s32[2] = w.z; s32[3] = w.w;
            __syncthreads();
            const int ch = tid >> 3, tg = tid & 7; unsigned short q[8];
#pragma unroll
            for (int i = 0; i < 8; ++i) q[i] = sT[(tg * 8 + i) * 66 + ch];
            u32x4 o; o.x = q[0] | ((unsigned)q[1] << 16); o.y = q[2] | ((unsigned)q[3] << 16); o.z = q[4] | ((unsigned)q[5] << 16); o.w = q[6] | ((unsigned)q[7] << 16);
            *(u32x4*)(T.dstT + ((size_t)(T.ch0 + ch) * TOK + tt * 64 + tg * 8) * 2) = o;
            __syncthreads();
        }
        x0 = n0; xm = nm; xp = np;
    }
}

struct ConvW { f32x4 w0a, w0b, w1a, w1b, w2a, w2b, ba, bb; };
__device__ __forceinline__ ConvW conv_w(const float* cw, const float* cb, int cc) { ConvW w;
    w.w0a = *(const f32x4*)(cw + cc); w.w0b = *(const f32x4*)(cw + cc + 4); w.w1a = *(const f32x4*)(cw + 4096 + cc); w.w1b = *(const f32x4*)(cw + 4096 + cc + 4);
    w.w2a = *(const f32x4*)(cw + 8192 + cc); w.w2b = *(const f32x4*)(cw + 8192 + cc + 4); w.ba = *(const f32x4*)(cb + cc); w.bb = *(const f32x4*)(cb + cc + 4); return w; }
__device__ __forceinline__ u32x4 conv8(const unsigned char* src, int ldsb, int tok, int col, const ConvW& W) {
    const int L = tok < TOKC ? 256 : 2048, pos = tok < TOKC ? (tok & 255) : ((tok - TOKC) & 2047);
    const unsigned char* sp = src + (size_t)tok * ldsb + (size_t)col * 2;
    const u32x4 x0 = *(const u32x4*)sp; u32x4 xm = {0, 0, 0, 0}, xp = {0, 0, 0, 0};
    if (pos > 0) xm = *(const u32x4*)(sp - ldsb);
    if (pos < L - 1) xp = *(const u32x4*)(sp + ldsb);
    float r[8];
    r[0] = silu_f(W.w0a[0] * bflo(xm.x) + W.w1a[0] * bflo(x0.x) + W.w2a[0] * bflo(xp.x) + W.ba[0]);
    r[1] = silu_f(W.w0a[1] * bfhi(xm.x) + W.w1a[1] * bfhi(x0.x) + W.w2a[1] * bfhi(xp.x) + W.ba[1]);
    r[2] = silu_f(W.w0a[2] * bflo(xm.y) + W.w1a[2] * bflo(x0.y) + W.w2a[2] * bflo(xp.y) + W.ba[2]);
    r[3] = silu_f(W.w0a[3] * bfhi(xm.y) + W.w1a[3] * bfhi(x0.y) + W.w2a[3] * bfhi(xp.y) + W.ba[3]);
    r[4] = silu_f(W.w0b[0] * bflo(xm.z) + W.w1b[0] * bflo(x0.z) + W.w2b[0] * bflo(xp.z) + W.bb[0]);
    r[5] = silu_f(W.w0b[1] * bfhi(xm.z) + W.w1b[1] * bfhi(x0.z) + W.w2b[1] * bfhi(xp.z) + W.bb[1]);
    r[6] = silu_f(W.w0b[2] * bflo(xm.w) + W.w1b[2] * bflo(x0.w) + W.w2b[2] * bflo(xp.w) + W.bb[2]);
    r[7] = silu_f(W.w0b[3] * bfhi(xm.w) + W.w1b[3] * bfhi(x0.w) + W.w2b[3] * bfhi(xp.w) + W.bb[3]);
    u32x4 w; w.x = cvt_pk(r[0], r[1]); w.y = cvt_pk(r[2], r[3]); w.z = cvt_pk(r[4], r[5]); w.w = cvt_pk(r[6], r[7]); return w;
}
__device__ __forceinline__ void conv_c_tile(const P& p, LAS unsigned char* lds, int ldsoff, int li, int pass, int gl, int tok0, int tid, unsigned char* gcopy) {
    const float* cw = p.ssd_conv_w + (size_t)li * 3 * 4096; const float* cb = p.ssd_conv_b + (size_t)li * 4096;
    const int c8 = (tid & 15) * 8; const ConvW W = conv_w(cw, cb, 3072 + 256 * pass + gl * 128 + c8);
#pragma unroll
    for (int k = 0; k < 4; ++k) { const int l = (tid >> 4) + 32 * k;
        const u32x4 v = conv8(p.ws + O_RAWC, 512, tok0 + l, gl * 128 + c8, W);
        int ob = (l & 15) * 64 + (c8 & 31) * 2; ob ^= ((ob >> 9) & 1) << 5;
        *(LAS u32x4*)(lds + ldsoff + ((l >> 4) * 4 + (c8 >> 5)) * 1024 + ob) = v;
        if (gcopy) *(u32x4*)(gcopy + ((size_t)(tok0 + l) * 256 + gl * 128 + c8) * 2) = v; }
}
constexpr int L_C = 0, L_B = 32768, L_X = 65536, L_DT = 131072, L_CUM = 135168, L_SS = 139264, L_CF = 139264, L_WT = 143360;
__device__ __forceinline__ bf16x8 scale8(bf16x8 x, f32x4 wa, f32x4 wb) {
    union { bf16x8 v; u32x4 u; } r;
    r.u.x = cvt_pk(bf2f(x[0]) * wa[0], bf2f(x[1]) * wa[1]); r.u.y = cvt_pk(bf2f(x[2]) * wa[2], bf2f(x[3]) * wa[3]);
    r.u.z = cvt_pk(bf2f(x[4]) * wb[0], bf2f(x[5]) * wb[1]); r.u.w = cvt_pk(bf2f(x[6]) * wb[2], bf2f(x[7]) * wb[3]);
    return r.v;
}
__device__ void phase_s1(const P& p, unsigned char* sm, LAS unsigned char* lds, int layer, int pass) {
    const int li = layer >> 1, tid = otid(), wid = __builtin_amdgcn_readfirstlane(tid >> 6), lane = tid & 63, fr = lane & 15, fq = lane >> 4;
    const int fo = frag_off(fr, fq);
    float* sDT = (float*)(sm + L_DT); float* sCUM = (float*)(sm + L_CUM); float* sCF = (float*)(sm + L_CF); float* sWT = (float*)(sm + L_WT);
    unsigned char* ws = p.ws;
    const int per = (1280 + (int)gridDim.x - 1) / (int)gridDim.x, hi_lo = (int)blockIdx.x * per, hi_hi = hi_lo + per < 1280 ? hi_lo + per : 1280;
    int cur_item = -1;
    for (int hi = hi_lo; hi < hi_hi; ++hi) {
        const int item = hi >> 2, r = hi & 3;
        const int chunk = item >> 1, gl = item & 1, tok0 = chunk * 128, g = pass * 2 + gl;
        if (item != cur_item) {
            cur_item = item;
            __syncthreads();
            conv_c_tile(p, lds, L_C, li, pass, gl, tok0, tid, ws + O_CS);
            { const float* cw = p.ssd_conv_w + (size_t)li * 3 * 4096; const float* cb = p.ssd_conv_b + (size_t)li * 4096;
              { const int c8 = (tid & 15) * 8; const ConvW W = conv_w(cw, cb, 2048 + 256 * pass + gl * 128 + c8);
#pragma unroll
                for (int k = 0; k < 4; ++k) { const int l = (tid >> 4) + 32 * k;
                    *(LAS u32x4*)(lds + L_B + off_b(l, c8 >> 3)) = conv8(ws + O_RAWB, 512, tok0 + l, gl * 128 + c8, W); } }
              { const int r_first = hi & 3, n_here = hi_hi - hi, r_last = r_first + n_here - 1 < 3 ? r_first + n_here - 1 : 3;
                for (int rr = r_first; rr <= r_last; ++rr) { const int c8 = rr * 64 + (tid & 7) * 8; const ConvW W = conv_w(cw, cb, 512 * pass + gl * 256 + c8);
#pragma unroll
                    for (int k = 0; k < 2; ++k) { const int l = (tid >> 3) + 64 * k;
                        *(LAS u32x4*)(lds + L_X + (c8 >> 7) * 32768 + off_b(l, (c8 & 127) >> 3)) = conv8(ws + O_RAWX, 1024, tok0 + l, gl * 256 + c8, W); } } } }
            { const int r4 = tid >> 7, pos = tid & 127, h = g * 4 + r4; const float* dr = (const float*)(ws + O_DTR) + (size_t)(tok0 + pos) * 64;
#pragma unroll
              for (int d = 0; d < 2; ++d) { const float raw = dr[d * 32 + h] + p.ssd_dt_bias[(li * 2 + d) * 32 + h];
                  const float dt = raw > 20.f ? raw : log1pf(__expf(raw)); const float a = -__expf(p.ssd_a_log[(li * 2 + d) * 32 + h]);
                  sDT[(r4 * 2 + d) * 128 + pos] = dt; sCUM[(r4 * 2 + d) * 128 + pos] = dt * a; } }
            __syncthreads();
            { float* cu = sCUM + wid * 128; const int d = wid & 1, r4 = wid >> 1, hl = gl * 4 + r4; const int e0 = d ? 127 - 2 * lane : 2 * lane, e1 = d ? e0 - 1 : e0 + 1;
              const float v0 = cu[e0], v1 = cu[e1], sv = v0 + v1; float inc = sv;
#pragma unroll
              for (int o = 1; o < 64; o <<= 1) { const float t = __shfl_up(inc, o); if (lane >= o) inc += t; }
              const float exc = inc - sv, c0 = exc + v0, c1 = exc + sv; cu[e0] = c0; cu[e1] = c1;
              float* CUMG = (float*)(ws + O_CUM);
              CUMG[((size_t)(tok0 + e0) * 2 + d) * 8 + hl] = c0; CUMG[((size_t)(tok0 + e1) * 2 + d) * 8 + hl] = c1;
              if (lane == 63) ((float*)(ws + O_DEC))[(chunk * 2 + d) * 8 + hl] = __expf(inc); }
            asm volatile("s_waitcnt vmcnt(0)" ::: "memory"); __syncthreads();
#pragma unroll
            for (int q = 0; q < 2; ++q) { const int idx = tid + q * 512, w8 = idx >> 7, pos = idx & 127, d = w8 & 1; const float* cu = sCUM + w8 * 128;
                const float cv = cu[pos], dtv = sDT[idx], ref = d ? cu[pos | 7] : cu[pos & ~7], tot = d ? cu[0] : cu[127];
                sCF[idx] = dtv * __expf(fminf(ref - cv, 80.f)); sWT[idx] = dtv * __expf(tot - cv); }
            { f32x4 cb[8];
#pragma unroll
              for (int st = 0; st < 8; ++st) cb[st] = (f32x4){0.f, 0.f, 0.f, 0.f};
#pragma unroll
              for (int kb = 0; kb < 4; ++kb) { const bf16x8 cf = LDFRAG(lds, L_C + (wid * 4 + kb) * 1024 + fo);
#pragma unroll
                  for (int st = 0; st < 8; ++st) { const bf16x8 bfr = LDFRAG(lds, L_B + off_b(16 * st + fr, 4 * kb + fq)); cb[st] = MFMA(bfr, cf, cb[st]); } }
              __syncthreads();
#pragma unroll
              for (int st = 0; st < 8; ++st) { int ob = fr * 64 + ((st & 1) * 16 + 4 * fq) * 2; ob ^= ((ob >> 9) & 1) << 5;
                  u32x2 w; w.x = cvt_pk(cb[st][0], cb[st][1]); w.y = cvt_pk(cb[st][2], cb[st][3]);
                  *(LAS u32x2*)(lds + L_C + (wid * 4 + (st >> 1)) * 1024 + ob) = w; } }
            __syncthreads();
        }
        { const int lt = wid, h = g * 4 + r; const float Dh = p.ssd_d[li * 32 + h];
          const float* cF = sCUM + (r * 2) * 128; const float* cR = cF + 128; const float* kF = sCF + (r * 2) * 128; const float* kR = kF + 128;
          f32x4 acc[4];
#pragma unroll
          for (int pt = 0; pt < 4; ++pt) acc[pt] = (f32x4){0.f, 0.f, 0.f, 0.f};
          const int l = lt * 16 + fr; const float cfl = cF[l], crl = cR[l];
#pragma unroll 1
          for (int kb = 0; kb < 4; ++kb) { const bf16x8 cbf = LDFRAG(lds, L_C + (lt * 4 + kb) * 1024 + fo); const int s0 = kb * 32 + fq * 8;
              bf16x8 xa[4];
#pragma unroll
              for (int pt = 0; pt < 4; ++pt) xa[pt] = trfrag(lds + L_X + (r >> 1) * 32768, lane, (r & 1) * 4 + pt, kb);
              const int rel = lt - 2 * kb;
              float mv[8];
              if (rel >= 2) { const float rf = __expf(cfl - cF[s0]); const f32x4 ka = *(const f32x4*)(kF + s0), kb4 = *(const f32x4*)(kF + s0 + 4);
#pragma unroll
                  for (int j = 0; j < 4; ++j) { mv[j] = bf2f(cbf[j]) * (rf * ka[j]); mv[4 + j] = bf2f(cbf[4 + j]) * (rf * kb4[j]); }
              } else if (rel < 0) { const float rr = __expf(crl - cR[s0 + 7]); const f32x4 ka = *(const f32x4*)(kR + s0), kb4 = *(const f32x4*)(kR + s0 + 4);
#pragma unroll
                  for (int j = 0; j < 4; ++j) { mv[j] = bf2f(cbf[j]) * (rr * ka[j]); mv[4 + j] = bf2f(cbf[4 + j]) * (rr * kb4[j]); }
              } else { const float rf = __expf(fminf(cfl - cF[s0], 0.f)), rr = __expf(fminf(crl - cR[s0 + 7], 0.f)), dsum = sDT[(r * 2) * 128 + l] + sDT[(r * 2 + 1) * 128 + l];
                  const f32x4 fa = *(const f32x4*)(kF + s0), fb = *(const f32x4*)(kF + s0 + 4), ra = *(const f32x4*)(kR + s0), rb = *(const f32x4*)(kR + s0 + 4);
#pragma unroll
                  for (int j = 0; j < 8; ++j) { const int sidx = s0 + j; const float kf = j < 4 ? fa[j & 3] : fb[j & 3], kr = j < 4 ? ra[j & 3] : rb[j & 3];
                      const float wgt = sidx < l ? rf * kf : (sidx > l ? rr * kr : dsum);
                      mv[j] = bf2f(cbf[j]) * wgt + (sidx == l ? Dh : 0.f); } }
              union { bf16x8 v; u32x4 u; } mf; mf.u.x = cvt_pk(mv[0], mv[1]); mf.u.y = cvt_pk(mv[2], mv[3]); mf.u.z = cvt_pk(mv[4], mv[5]); mf.u.w = cvt_pk(mv[6], mv[7]);
#pragma unroll
              for (int pt = 0; pt < 4; ++pt) acc[pt] = MFMA(xa[pt], mf.v, acc[pt]); }
          unsigned char* yp = ws + O_YD + ((size_t)(tok0 + l) * 512 + gl * 256 + r * 64 + 4 * fq) * 2;
#pragma unroll
          for (int pt = 0; pt < 4; ++pt) { u32x2 w; w.x = cvt_pk(acc[pt][0], acc[pt][1]); w.y = cvt_pk(acc[pt][2], acc[pt][3]); *(u32x2*)(yp + pt * 32) = w; } }
        { const int d = wid & 1, pq = wid >> 1, hl = gl * 4 + r; const float* wt = sWT + (r * 2 + d) * 128;
          f32x4 acc[8];
#pragma unroll
          for (int a = 0; a < 8; ++a) acc[a] = (f32x4){0.f, 0.f, 0.f, 0.f};
#pragma unroll
          for (int kb = 0; kb < 4; ++kb) { const int l0 = kb * 32 + fq * 8; const f32x4 wa = *(const f32x4*)(wt + l0), wb = *(const f32x4*)(wt + l0 + 4);
              const bf16x8 xb = scale8(trfrag(lds + L_X + (r >> 1) * 32768, lane, (r & 1) * 4 + pq, kb), wa, wb);
#pragma unroll
              for (int n2 = 0; n2 < 8; ++n2) { const bf16x8 af = trfrag(lds + L_B, lane, n2, kb); acc[n2] = MFMA(af, xb, acc[n2]); } }
          unsigned char* sp = ws + O_ST + ((size_t)((chunk * 2 + d) * 8 + hl) * 64) * 256;
#pragma unroll
          for (int n2 = 0; n2 < 8; ++n2) { u32x2 w; w.x = cvt_pk(acc[n2][0], acc[n2][1]); w.y = cvt_pk(acc[n2][2], acc[n2][3]);
              *(u32x2*)(sp + ((size_t)(pq * 16 + fr) * 128 + n2 * 16 + 4 * fq) * 2) = w; } }
    }
}
__device__ void phase_s2(const P& p, int layer, int pass) {
    const int li = layer >> 1; unsigned char* ws = p.ws;
    const long gt = (long)blockIdx.x * 512 + otid(), gn = (long)gridDim.x * 512;
    const float* DEC = (const float*)(ws + O_DEC);
    for (long it = gt; it < 393216; it += gn) {
        const int n8 = (int)(it & 15), pp = (int)(it >> 4) & 63, hl = (int)(it >> 10) & 7, d = (int)(it >> 13) & 1, seq = (int)(it >> 14);
        const int nc = seq < 16 ? 2 : 16, c0 = seq < 16 ? seq * 2 : 32 + (seq - 16) * 16, h = pass * 8 + hl;
        f32x4 ha = (f32x4){0.f, 0.f, 0.f, 0.f}, hb = ha;
        if (seq >= 16) { const float* s0 = p.state + ((((size_t)(seq - 16) * 2 + li) * 2 + d) * 32 + h) * 8192 + pp * 128 + n8 * 8; ha = *(const f32x4*)s0; hb = *(const f32x4*)(s0 + 4); }
        const int nb = nc < 4 ? nc : 4;
        for (int k0 = 0; k0 < nc; k0 += nb) {
            u32x4 sv[4]; float dc[4]; unsigned char* pt[4];
#pragma unroll
            for (int j = 0; j < 4; ++j) if (j < nb) { const int k = k0 + j, c = d ? c0 + nc - 1 - k : c0 + k; dc[j] = DEC[(c * 2 + d) * 8 + hl];
                pt[j] = ws + O_ST + (((size_t)((c * 2 + d) * 8 + hl) * 64 + pp) * 128 + n8 * 8) * 2; sv[j] = *(const u32x4*)pt[j]; }
#pragma unroll
            for (int j = 0; j < 4; ++j) if (j < nb) { const float dec = dc[j];
                u32x4 w; w.x = cvt_pk(ha[0], ha[1]); w.y = cvt_pk(ha[2], ha[3]); w.z = cvt_pk(hb[0], hb[1]); w.w = cvt_pk(hb[2], hb[3]);
                *(u32x4*)pt[j] = w;
                ha[0] = ha[0] * dec + bflo(sv[j].x); ha[1] = ha[1] * dec + bfhi(sv[j].x); ha[2] = ha[2] * dec + bflo(sv[j].y); ha[3] = ha[3] * dec + bfhi(sv[j].y);
                hb[0] = hb[0] * dec + bflo(sv[j].z); hb[1] = hb[1] * dec + bfhi(sv[j].z); hb[2] = hb[2] * dec + bflo(sv[j].w); hb[3] = hb[3] * dec + bfhi(sv[j].w); } }
        if (seq < 16) { float* o = p.out + OUT_STATE_OFF + ((((size_t)seq * 2 + li) * 2 + d) * 32 + h) * 8192 + pp * 128 + n8 * 8; *(f32x4*)o = ha; *(f32x4*)(o + 4) = hb; }
    }
}
__device__ void phase_s3(const P& p, unsigned char* sm, LAS unsigned char* lds, int layer, int pass) {
    const int li = layer >> 1, tid = otid(), wid = __builtin_amdgcn_readfirstlane(tid >> 6), lane = tid & 63, fr = lane & 15, fq = lane >> 4;
    const int fo = frag_off(fr, fq);
    float* sSC = (float*)(sm + L_DT); float* sSS = (float*)(sm + L_SS);
    unsigned char* ws = p.ws;
    const int per = (1280 + (int)gridDim.x - 1) / (int)gridDim.x, q_lo = (int)blockIdx.x * per, q_hi = q_lo + per < 1280 ? q_lo + per : 1280;
    const int r = wid >> 1, ph = wid & 1;
    int cur_item = -1;
    bf16x8 hh[2][4][2];
#pragma unroll
    for (int d = 0; d < 2; ++d)
#pragma unroll
        for (int kb = 0; kb < 4; ++kb) { hh[d][kb][0] = (bf16x8){0, 0, 0, 0, 0, 0, 0, 0}; hh[d][kb][1] = hh[d][kb][0]; }
    for (int qi = q_lo; qi < q_hi; ++qi) {
        const int item = qi >> 2, lq = qi & 3;
        const int chunk = item >> 1, gl = item & 1, tok0 = chunk * 128, g = pass * 2 + gl;
        if (item != cur_item) {
            cur_item = item;
            __syncthreads();
            stage_tile(lds, L_C, ws + O_CS + ((size_t)tok0 * 256 + gl * 128) * 2, 512, 8, 4, wid, lane);
            { const unsigned char* hin0 = ws + O_ST + ((size_t)((chunk * 2) * 8 + gl * 4 + r) * 64 + ph * 32) * 256 + ((size_t)fr * 128 + fq * 8) * 2;
#pragma unroll
              for (int d = 0; d < 2; ++d)
#pragma unroll
                  for (int kb = 0; kb < 4; ++kb) { hh[d][kb][0] = *(const bf16x8*)(hin0 + (size_t)d * 131072 + kb * 64); hh[d][kb][1] = *(const bf16x8*)(hin0 + (size_t)d * 131072 + kb * 64 + 16 * 256); } }
            { const float* CUMG = (const float*)(ws + O_CUM);
#pragma unroll
              for (int q = 0; q < 2; ++q) { const int idx = tid + q * 512, l = idx & 127, w8 = idx >> 7, r4 = w8 >> 1, d = w8 & 1;
                  sSC[w8 * 128 + l] = __expf(CUMG[((size_t)(tok0 + l) * 2 + d) * 8 + gl * 4 + r4]); } }
            asm volatile("s_waitcnt vmcnt(0)" ::: "memory"); __syncthreads();
        }
        f32x4 acc[2][2], aR[2][2], ggv[2];
        { const float* ng = p.ssd_norm_g + (size_t)li * 2048 + g * 256 + r * 64 + ph * 32 + 4 * fq; ggv[0] = *(const f32x4*)ng; ggv[1] = *(const f32x4*)(ng + 16); }
        u32x2 ydv[2][2], zzv[2][2];
#pragma unroll
        for (int i = 0; i < 2; ++i)
#pragma unroll
            for (int pt = 0; pt < 2; ++pt) { const size_t o = ((size_t)(tok0 + (lq * 2 + i) * 16 + fr) * 512 + gl * 256 + r * 64 + ph * 32 + pt * 16 + 4 * fq) * 2;
                ydv[i][pt] = *(const u32x2*)(ws + O_YD + o); zzv[i][pt] = *(const u32x2*)(ws + O_Z + o); }
#pragma unroll
        for (int i = 0; i < 2; ++i) { acc[i][0] = (f32x4){0.f, 0.f, 0.f, 0.f}; acc[i][1] = acc[i][0]; aR[i][0] = acc[i][0]; aR[i][1] = acc[i][0]; }
#pragma unroll
        for (int kb = 0; kb < 4; ++kb)
#pragma unroll
            for (int i = 0; i < 2; ++i) { const bf16x8 cf = LDFRAG(lds, L_C + ((lq * 2 + i) * 4 + kb) * 1024 + fo);
                acc[i][0] = MFMA(hh[0][kb][0], cf, acc[i][0]); acc[i][1] = MFMA(hh[0][kb][1], cf, acc[i][1]);
                aR[i][0] = MFMA(hh[1][kb][0], cf, aR[i][0]); aR[i][1] = MFMA(hh[1][kb][1], cf, aR[i][1]); }
#pragma unroll
        for (int i = 0; i < 2; ++i) { const int l = (lq * 2 + i) * 16 + fr; float ss = 0.f;
            const float sf = sSC[(r * 2) * 128 + l], sr = sSC[(r * 2 + 1) * 128 + l];
#pragma unroll
            for (int pt = 0; pt < 2; ++pt) { const u32x2 yd = ydv[i][pt], zz = zzv[i][pt];
                f32x4 v = acc[i][pt] * sf + aR[i][pt] * sr;
                v[0] = (v[0] + bflo(yd.x)) * silu_f(bflo(zz.x)); v[1] = (v[1] + bfhi(yd.x)) * silu_f(bfhi(zz.x));
                v[2] = (v[2] + bflo(yd.y)) * silu_f(bflo(zz.y)); v[3] = (v[3] + bfhi(yd.y)) * silu_f(bfhi(zz.y));
                acc[i][pt] = v; ss += v[0] * v[0] + v[1] * v[1] + v[2] * v[2] + v[3] * v[3]; }
            ss += __shfl_xor(ss, 16); ss += __shfl_xor(ss, 32);
            if (fq == 0) sSS[(qi & 1) * 256 + wid * 32 + i * 16 + fr] = ss; }
        __syncthreads();
#pragma unroll
        for (int i = 0; i < 2; ++i) { const int l = (lq * 2 + i) * 16 + fr; float tot = 0.f;
#pragma unroll
            for (int w = 0; w < 8; ++w) tot += sSS[(qi & 1) * 256 + w * 32 + i * 16 + fr];
            const float rstd = rsqrtf(tot * (1.0f / 256.f) + 1e-6f);
#pragma unroll
            for (int pt = 0; pt < 2; ++pt) { const f32x4 gg = ggv[pt]; const f32x4 v = acc[i][pt];
                u32x2 w; w.x = cvt_pk(v[0] * rstd * gg[0], v[1] * rstd * gg[1]); w.y = cvt_pk(v[2] * rstd * gg[2], v[3] * rstd * gg[3]);
                *(u32x2*)(ws + O_YN + ((size_t)(tok0 + l) * 2048 + g * 256 + r * 64 + ph * 32 + pt * 16 + 4 * fq) * 2) = w; } }
    }
}
__device__ void phase_final(const P& p) {
    const int tid = otid(), lane = tid & 63, gw = blockIdx.x * 8 + (tid >> 6), nw = gridDim.x * 8;
    const int rpw = (TOK + nw - 1) / nw, r_lo = gw * rpw, r_hi = r_lo + rpw < TOK ? r_lo + rpw : TOK;
    f32x4 g[4];
#pragma unroll
    for (int i = 0; i < 4; ++i) g[i] = *(const f32x4*)(p.final_norm_g + i * 256 + lane * 4);
    for (int t0 = r_lo; t0 < r_hi; t0 += 4) {
        f32x4 v[4][4]; float ss[4];
#pragma unroll
        for (int j = 0; j < 4; ++j) { const int t = t0 + j < r_hi ? t0 + j : r_hi - 1; const float* xr = p.out + (size_t)t * 1024;
#pragma unroll
            for (int i = 0; i < 4; ++i) v[j][i] = *(const f32x4*)(xr + i * 256 + lane * 4); }
#pragma unroll
        for (int j = 0; j < 4; ++j) { float a = 0.f;
#pragma unroll
            for (int i = 0; i < 4; ++i) a += v[j][i][0] * v[j][i][0] + v[j][i][1] * v[j][i][1] + v[j][i][2] * v[j][i][2] + v[j][i][3] * v[j][i][3];
            ss[j] = a; }
#pragma unroll
        for (int o = 32; o >= 1; o >>= 1) {
#pragma unroll
            for (int j = 0; j < 4; ++j) ss[j] += __shfl_xor(ss[j], o); }
#pragma unroll
        for (int j = 0; j < 4; ++j) if (t0 + j < r_hi) { const float rstd = rsqrtf(ss[j] * (1.0f / 1024.f) + 1e-6f); float* xr = p.out + (size_t)(t0 + j) * 1024;
#pragma unroll
            for (int i = 0; i < 4; ++i) *(f32x4*)(xr + i * 256 + lane * 4) = v[j][i] * rstd * g[i]; }
    }
}

__global__ void __launch_bounds__(512, 2) mega(P p) {
    extern __shared__ __attribute__((aligned(16))) unsigned char smem[];
    LAS unsigned char* lds = (LAS unsigned char*)smem;
    cg::grid_group grid = cg::this_grid();
    XcdBarrier xb; xb.bar = (unsigned*)(p.ws + WS_BAR); xb.x = xb_xcc_id(); xb.st = (volatile LAS unsigned*)(lds + 147456);
    if (threadIdx.x == 0) { xb.st[0] = 0u; xb.st[1] = 0u; (void)xb_add(&xb.bar[XB_XCNT(xb.x)], 1u); }
    __syncthreads();
    const int G = gridDim.x, c = blockIdx.x;
    if (p.ph0 < 0) grid.sync();
#ifndef REP_MASK
#define REP_MASK 0
#endif
    for (int ph = p.ph0; ph < p.ph1; ++ph) {
        int kind, layer = 0, pass = 0;
        if (ph < 2) kind = ph;
        else if (ph == 54) kind = 13;
        else { const int q = ph - 2, blk = q / 26; int r = q - blk * 26; layer = blk * 2;
            if (r < 8) { if (r < 6) { pass = r / 3; kind = 2 + (r - pass * 3); } else kind = r == 6 ? 5 : 6; }
            else { r -= 8; layer += 1; if (r == 0) kind = 7; else if (r == 17) kind = 6; else { pass = (r - 1) / 4; const int sub = r - 1 - pass * 4; kind = sub == 0 ? 8 : 9 + sub; } } }
        const int cls = (kind == 3 || kind == 8) ? 1 : kind == 5 ? 2 : kind == 4 ? 4 : kind == 9 ? 8 : kind == 10 ? 16 : kind == 12 ? 32 : (kind == 2 || kind == 7) ? 64 : kind < 2 ? 128 : 0;
        const int nrep = ((REP_MASK) & cls) ? 2 : 1;
        bool skip_bar = false;
        for (int rep = 0; rep < nrep; ++rep) {
            if (rep) grid_barrier(xb);
            switch (kind) {
            case 0: phase_prep0(p, smem); break;
            case 1: { UF_Prep1 uf{p.ws, G, c}; gemm_phase<true>(lds, 512, 2048, 4, 1 << 30, 0L, 0L, uf, EpiBf16{}); __syncthreads(); phase_normE(p, smem, 0, 0); } break;
            case 2: if ((layer == 0 && pass == 0) || pass == 1) skip_bar = true; else phase_normE(p, smem, layer, pass); break;
            case 3: { UF_G1E uf{&p, layer >> 1, pass, G, c}; gemm_phase<true>(lds, 2048, 2048, 16, 1 << 30, 0L, 0L, uf, EpiBf16{}); } break;
            case 4: phase_e3(p, layer, pass); if (pass == 0) phase_normE(p, smem, layer, 1); break;
            case 5: { UF_E4L uf{&p, G, c}; gemm_phase<true>(lds, 4096, 8192, 32, 16, 0L, 2048L, uf, EpiBf16{});
                      UF_E4C uc{&p, G, c}; gemm_phase<true>(lds, 1024, 1024, 8, 1 << 30, 0L, 0L, uc, EpiBf16{}); } break;
            case 6: { const bool even = (layer & 1) == 0; const int lda = even ? 2048 : 4096, tseg = even ? 16 : (1 << 30); const long segoff = even ? (long)(E_YB - E_YA) - 2048L : 0L;
                      UF_G2 uf{&p, layer, 0, G, c}; gemm_phase<false, false>(lds, lda, 4096, 32, tseg, segoff, 0L, uf, EpiResT<false>{});
                      UF_G2 uh{&p, layer, 1, G, c}; gemm_phase<false, true>(lds, lda, 4096, 32, tseg, segoff, 0L, uh, EpiResT<true>{});
                      if (layer < 3) {
                          const int nh = G > 128 ? 128 : 0, rank = c - nh, nblk = G - nh;
                          if (rank >= 0) { __syncthreads(); if (even) conv_odd(p, smem, layer + 1, rank, nblk); else conv_even(p, smem, layer + 1, rank, nblk); } } } break;
            case 7: phase_normO(p, smem, layer); break;
            case 8: { UF_G1O uf{p.ws, pass, pass == 0 ? 7 : 6, G, c}; gemm_phase<true>(lds, 2048, 2048, 16, 1 << 30, 0L, 0L, uf, EpiBf16{}); } break;
            case 9: phase_o3(p, smem, layer, pass); break;
            case 10: phase_s1(p, smem, lds, layer, pass); break;
            case 11: phase_s2(p, layer, pass); break;
            case 12: phase_s3(p, smem, lds, layer, pass); break;
            default: phase_final(p); break;
            }
        }
        if (!skip_bar && ph + 1 < p.ph1) { grid_barrier(xb); if ((REP_MASK) & 512) grid_barrier(xb); }
    }
}
constexpr int N_PHASES = 55;

extern "C" void kernel_launch(void* const* d_in, const int* in_sizes, int n_in, void* d_out, int out_size, void* d_ws, size_t ws_size, hipStream_t stream) {
    static int grid = 0;
    if (grid == 0) {
        if (ws_size < WS_NEED) { fprintf(stderr, "kernel_launch: workspace too small: %zu < %zu\n", ws_size, (size_t)WS_NEED); grid = -1; return; }
        int dev = 0, cus = 0, per_cu = 0;
        hipGetDevice(&dev); hipDeviceGetAttribute(&cus, hipDeviceAttributeMultiprocessorCount, dev);
        hipFuncSetAttribute((const void*)mega, hipFuncAttributeMaxDynamicSharedMemorySize, LDS_BYTES);
        hipOccupancyMaxActiveBlocksPerMultiprocessor(&per_cu, (const void*)mega, 512, LDS_BYTES);
        if (per_cu < 1) { fprintf(stderr, "kernel_launch: occupancy query says %d blocks per CU\n", per_cu); grid = -1; return; }
        grid = cus;
        if (grid > 256) grid = 256;
    }
    if (grid < 0) return;
    hipMemsetAsync((char*)d_ws + WS_BAR, 0, 16384, stream);
    P p{};
    const float** pp = (const float**)&p;
    for (int i = 0; i < 20; ++i) pp[i] = (const float*)d_in[i];
    p.out = (float*)d_out; p.ws = (unsigned char*)d_ws; p.ph0 = 0; p.ph1 = N_PHASES;
#ifdef DBG_PH1
    p.ph1 = DBG_PH1;
#endif
    void* args[] = {&p};
    hipError_t e = hipLaunchCooperativeKernel((const void*)mega, dim3(grid), dim3(512), args, LDS_BYTES, stream);
    if (e != hipSuccess) fprintf(stderr, "cooperative launch failed: %s (grid %d)\n", hipGetErrorString(e), grid);
}
```

```cpp
#include <hip/hip_runtime.h>
#include <hip/hip_cooperative_groups.h>
#include <cstdio>
#include <cstring>
namespace cg = cooperative_groups;

#define LAS __attribute__((address_space(3)))
typedef unsigned short bf16_t;
typedef short bf16x8 __attribute__((ext_vector_type(8)));
typedef float f32x4 __attribute__((ext_vector_type(4)));
typedef unsigned u32x4 __attribute__((ext_vector_type(4)));
typedef unsigned u32x2 __attribute__((ext_vector_type(2)));

constexpr int TOK = 20480, TOKC = 4096;
constexpr size_t SLOT = 2097152;
constexpr size_t OUT_STATE_OFF = (size_t)TOK * 1024;

constexpr size_t WS_BAR = 0;
constexpr size_t WS_MOD = 16384;
constexpr size_t WS_TC = 524288;
constexpr size_t WS_ALC = 786432;
constexpr size_t WS_WF = 1048576;
constexpr size_t WS_BIG = 9437184;
constexpr size_t WS_WUBF = WS_BIG;
constexpr size_t E_VTC = WS_BIG;
constexpr size_t E_VTL = E_VTC + 16777216;
constexpr size_t E_ZA = WS_BIG + 83886080;
constexpr size_t E_YB = E_ZA + 41943040;
constexpr int E_T0 = 38, E_T1 = 42;
constexpr size_t E_PS = (size_t)E_T1 * 256 * 2048;
constexpr size_t E_HM = E_YB + 41943040;
constexpr size_t E_PL = E_HM + E_PS;
constexpr size_t E_YA = E_PL;
constexpr size_t E_END = E_PL + 4 * E_PS;
constexpr size_t O_WIN = WS_BIG;
constexpr size_t O_WOUT = O_WIN + 13107200;
constexpr size_t O_HM = O_WOUT + 4194304;
constexpr size_t O_YN = O_HM + 41943040;
constexpr size_t O_DTR = O_YN + 83886080;
constexpr size_t O_Z = O_DTR + 5242880;
constexpr size_t O_RAWX = O_Z + 20971520;
constexpr size_t O_RAWB = O_RAWX + 20971520;
constexpr size_t O_RAWC = O_RAWB + 10485760;
constexpr size_t O_XT = O_RAWC + 10485760;
constexpr size_t O_BS = O_XT + 20971520;
constexpr size_t O_BT = O_BS + 10485760;
constexpr size_t O_CS = O_BT + 10485760;
constexpr size_t O_ST = O_XT;
constexpr size_t O_YD = O_CS + 10485760;
constexpr size_t O_CUM = O_YD + 20971520;
constexpr size_t O_DEC = O_CUM + 1310720;
constexpr size_t O_END = O_DEC + 16384;
constexpr size_t WS_NEED = (O_END > E_END ? O_END : E_END);

constexpr int LDS_BYTES = 147520;

struct P {
    const float *x_prompt, *x_sample, *state, *c, *c_ctx, *w_mod, *b_mod, *norm_g, *fc_w_in, *fc_conv_w, *fc_w_out, *ssd_w_in, *ssd_conv_w,
        *ssd_conv_b, *ssd_dt_bias, *ssd_a_log, *ssd_d, *ssd_norm_g, *ssd_w_out, *final_norm_g;
    float* out; unsigned char* ws; int ph0, ph1;
};

typedef __bf16 bf16v2 __attribute__((ext_vector_type(2)));
typedef float f32x2 __attribute__((ext_vector_type(2)));
__device__ __forceinline__ unsigned cvt_pk(float lo, float hi) { const f32x2 v = {lo, hi}; const bf16v2 b = __builtin_convertvector(v, bf16v2); return __builtin_bit_cast(unsigned, b); }
__device__ __forceinline__ float bflo(unsigned u) { return __uint_as_float(u << 16); }
__device__ __forceinline__ float bfhi(unsigned u) { return __uint_as_float(u & 0xFFFF0000u); }
__device__ __forceinline__ float bf2f(short s) { return __uint_as_float(((unsigned)(unsigned short)s) << 16); }
__device__ __forceinline__ float silu_f(float x) { return x * __builtin_amdgcn_rcpf(1.0f + __expf(-x)); }
__device__ __forceinline__ unsigned char* slot_ptr(const P& p, int b, int i) { return (unsigned char*)(p.out + OUT_STATE_OFF) + ((size_t)b * 2 + i) * SLOT; }
__device__ __forceinline__ int cond_of_tile(int pm) { return pm < 16 ? 0 : 1 + ((pm - 16) >> 3); }
__device__ __forceinline__ int cond_of_tok(int tok) { return tok < TOKC ? 0 : 1 + ((tok - TOKC) >> 11); }

__device__ __forceinline__ int otid() { int t; asm volatile("v_mov_b32 %0, %1" : "=v"(t) : "v"((int)threadIdx.x)); return t; }
__device__ __forceinline__ int frag_off(int fr, int fq) { int ob = fr * 64 + fq * 16; return ob ^ (((ob >> 9) & 1) << 5); }
__device__ __forceinline__ void stage_tile(LAS unsigned char* lds, int ldsoff, const unsigned char* g, long ldb, int R16, int K32, int wid, int lane) {
    const int b = lane * 16, swz = b ^ (((b >> 9) & 1) << 5), rr = swz >> 6, cc = (swz & 63) >> 1;
    for (int st = wid; st < R16 * K32; st += 8) {
        const int rb = st / K32, kb = st - rb * K32;
        const unsigned char* src = g + (long)(rb * 16 + rr) * ldb + (kb * 32 + cc) * 2;
        __builtin_amdgcn_global_load_lds((const unsigned*)src, (LAS unsigned*)(lds + ldsoff + st * 1024), 16, 0, 0);
    }
}
#define LDFRAG(lds, off) (*(const LAS bf16x8*)((lds) + (off)))
typedef short s16x4 __attribute__((ext_vector_type(4)));
__device__ __forceinline__ unsigned off_b(unsigned row, unsigned ch) { return 256u * row + 16u * (ch ^ (((row & 3u) << 2) | ((row >> 2) & 3u))); }
__device__ __forceinline__ void stage_img(LAS unsigned char* lds, int ldsoff, const unsigned char* g, long ld, int wid, int lane) {
    const unsigned rr = lane >> 4, pch = lane & 15;
    for (int i = wid; i < 32; i += 8) { const unsigned row = 4 * i + rr, ch = pch ^ (((row & 3u) << 2) | ((row >> 2) & 3u));
        __builtin_amdgcn_global_load_lds((const unsigned*)(g + (long)row * ld + ch * 16), (LAS unsigned*)(lds + ldsoff + i * 1024), 16, 0, 0); }
}
__device__ __forceinline__ bf16x8 trfrag(LAS unsigned char* img, int lane, int c, int ks) {
    const unsigned g = lane >> 4, q = (lane & 15) >> 2, pp = lane & 3;
    const unsigned a0 = off_b(32 * ks + 8 * g + q, 2 * c + (pp >> 1)) + 8 * (pp & 1), a1 = off_b(32 * ks + 8 * g + 4 + q, 2 * c + (pp >> 1)) + 8 * (pp & 1);
    const s16x4 x = __builtin_amdgcn_ds_read_tr16_b64_v4i16((LAS s16x4*)(img + a0)), y = __builtin_amdgcn_ds_read_tr16_b64_v4i16((LAS s16x4*)(img + a1));
    return (bf16x8){x[0], x[1], x[2], x[3], y[0], y[1], y[2], y[3]};
}
#define MFMA(a, b, c) __builtin_amdgcn_mfma_f32_16x16x32_bf16((a), (b), (c), 0, 0, 0)

#define XB_TMO      128
#define XB_XCNT(j)  (256  + 64 * (j))
#define XB_XSUB(j)  (1280 + 64 * (j))
#define XB_XGEN(j)  (2304 + 64 * (j))
#define XB_TOP      3328
#define XB_TOPGEN   3392
#define XB_SPIN_CAP (1u << 22)
__device__ __forceinline__ unsigned xb_ld(unsigned* p)              { return __hip_atomic_load(p, __ATOMIC_RELAXED, __HIP_MEMORY_SCOPE_AGENT); }
__device__ __forceinline__ unsigned xb_add(unsigned* p, unsigned v) { return __hip_atomic_fetch_add(p, v, __ATOMIC_RELAXED, __HIP_MEMORY_SCOPE_AGENT); }
__device__ __forceinline__ unsigned xb_xcc_id() { return (unsigned)__builtin_amdgcn_s_getreg((3 << 11) | 20) & 0xFu; }
#define XB_SPIN(cond, bar) do { unsigned _sp = 0; while (cond) { __builtin_amdgcn_s_sleep(1); \
    if ((++_sp & 255u) == 0u) { if (xb_ld(&(bar)[XB_TMO])) break; if (_sp > XB_SPIN_CAP) { atomicAdd(&(bar)[XB_TMO], 1u); break; } } } } while (0)
struct XcdBarrier { unsigned* bar; unsigned x; volatile LAS unsigned* st; };
__device__ __forceinline__ void xcd_barrier_complete(unsigned* bar, unsigned x, unsigned& nloc, unsigned& nx) {
    const unsigned G = gridDim.x;
    unsigned sum, cnt, mine, sp = 0u;
    for (;;) {
        sum = 0u; cnt = 0u; mine = 0u;
#pragma unroll
        for (unsigned j = 0; j < 16; ++j) { const unsigned c = xb_ld(&bar[XB_XCNT(j)]); sum += c; cnt += (c > 0u) ? 1u : 0u; mine = (j == x) ? c : mine; }
        if (sum == G) break;
        __builtin_amdgcn_s_sleep(1);
        if ((++sp & 255u) == 0u) { if (xb_ld(&bar[XB_TMO])) break; if (sp > XB_SPIN_CAP) { atomicAdd(&bar[XB_TMO], 1u); break; } }
    }
    nloc = mine > 0u ? mine : 1u; nx = cnt > 0u ? cnt : 1u;
}
__device__ __forceinline__ void grid_barrier(const XcdBarrier& b) {
    asm volatile("s_waitcnt vmcnt(0)" ::: "memory");
    __syncthreads();
    if (threadIdx.x == 0) {
        unsigned* bar = b.bar;
        __builtin_amdgcn_s_waitcnt(0);
        unsigned nloc = b.st[0], nx = b.st[1];
        if (nloc == 0u) { xcd_barrier_complete(bar, b.x, nloc, nx); b.st[0] = nloc; b.st[1] = nx; }
        const unsigned old = xb_add(&bar[XB_XSUB(b.x)], 1u);
        const unsigned gen = old / nloc;
        if (old + 1u == (gen + 1u) * nloc) {
            __builtin_amdgcn_fence(__ATOMIC_RELEASE, "agent");
            asm volatile("s_waitcnt vmcnt(0)" ::: "memory");
            const unsigned og = xb_add(&bar[XB_TOP], 1u);
            const unsigned tg = og / nx;
            if (og + 1u == (tg + 1u) * nx) xb_add(&bar[XB_TOPGEN], 1u);
            else XB_SPIN(xb_ld(&bar[XB_TOPGEN]) == tg, bar);
            __builtin_amdgcn_fence(__ATOMIC_ACQUIRE, "agent");
            xb_add(&bar[XB_XGEN(b.x)], 1u);
            asm volatile("s_waitcnt vmcnt(0)" ::: "memory");
        } else {
            XB_SPIN(xb_ld(&bar[XB_XGEN(b.x)]) == gen, bar);
            __builtin_amdgcn_fence(__ATOMIC_ACQUIRE, "agent");
            asm volatile("s_waitcnt vmcnt(0)" ::: "memory");
        }
    }
    __syncthreads();
}

struct Unit { const unsigned char* A; const unsigned char* B; unsigned char* O; const unsigned char* X; const float* G; int ldo; int kind; float scale; };
constexpr int HTB = 128 * 64 * 2;
__device__ __forceinline__ int lds_byte(int r, int c) { const int st = (r >> 4) * 2 + (c >> 5), rr = r & 15, cc = c & 31, ob = rr * 64 + cc * 2; return st * 1024 + (ob ^ (((ob >> 9) & 1) << 5)); }
__device__ __forceinline__ void stage_rc(int b, int& R, int& C) { const int st = b / 1024, sb = b % 1024, swz = sb ^ (((sb >> 9) & 1) << 5); R = (st >> 1) * 16 + swz / 64; C = (st & 1) * 32 + (swz % 64) / 2; }
__device__ __forceinline__ int perm32(int rho) { const int n = rho >> 4, i = rho & 15; return 8 * (i >> 2) + 4 * n + (i & 3); }
__device__ __forceinline__ void tile_order(int L, int nM, int nN, int& pm, int& pn) {
    const int nwg = nM * nN; int wgid = L;
    { const int q = nwg / 8, r = nwg % 8, xcd = wgid % 8, off = wgid / 8; wgid = (xcd < r ? xcd * (q + 1) : r * (q + 1) + (xcd - r) * q) + off; }
    const int nig = 8 * nN, gid = wgid / nig, fm = gid * 8, gsz = (nM - fm) < 8 ? (nM - fm) : 8;
    pm = fm + ((wgid % nig) % gsz); pn = (wgid % nig) / gsz;
}

template <bool PERM, bool HALFM = false, class UF, class Epi>
__device__ __forceinline__ void gemm_phase(LAS unsigned char* lds, const int lda, const int ldb, const int nt, const int tseg, const long segoff, const long segoffB, const UF& uf, const Epi& E) {
    const int tid = otid(), wid = __builtin_amdgcn_readfirstlane(tid >> 6), lane = tid & 63, wr = wid >> 2, wc = wid & 3, fr = lane & 15, fq = lane >> 4;
    unsigned voffA[2], voffB[2];
#pragma unroll
    for (int i = 0; i < 2; ++i) { int R, C; stage_rc(tid * 16 + i * 8192, R, C); const int Rb = PERM ? ((R & ~31) + perm32(R & 31)) : R;
        voffA[i] = (unsigned)(R * lda + C * 2); voffB[i] = (unsigned)(Rb * ldb + C * 2); }
    const long kstep = 128;
    const long hstepA = 128L * lda, hstepB = 128L * ldb;
    const unsigned ldsw = (unsigned)wid * 1024u;
    const int aoff = lds_byte(wr * 64 + fr, fq * 8), boff = lds_byte(wc * 32 + fr, fq * 8);
#define PG8_SA(b, h) (((b) * 2 + (h)) * HTB)
#define PG8_SB(b, h) ((4 + (b) * 2 + (h)) * HTB)
#define PG8_STAGE(bufoff, gbase, voff) do { _Pragma("unroll") for (int _i = 0; _i < 2; ++_i) \
        __builtin_amdgcn_global_load_lds((const unsigned*)((const unsigned char*)(gbase) + (voff)[_i]), (LAS unsigned*)(lds + (bufoff) + ldsw + _i * 8192), 16, 0, 0); } while (0)
#define PG8_LDA(dst, b, h) do { if (HALFM && (h) == 1) break; _Pragma("unroll") for (int m = 0; m < 4; ++m) _Pragma("unroll") for (int k = 0; k < 2; ++k) dst[m][k] = *(const LAS bf16x8*)(lds + PG8_SA(b, h) + aoff + m * 2048 + k * 1024); } while (0)
#define PG8_LDB(dst, b, h) do { _Pragma("unroll") for (int n = 0; n < 2; ++n) _Pragma("unroll") for (int k = 0; k < 2; ++k) dst[n][k] = *(const LAS bf16x8*)(lds + PG8_SB(b, h) + boff + n * 2048 + k * 1024); } while (0)
#define PG8_MMA(ai, bj, At, Bt) do { if (HALFM && (ai) == 1) break; __builtin_amdgcn_s_setprio(1); _Pragma("unroll") for (int m = 0; m < 4; ++m) _Pragma("unroll") for (int n = 0; n < 2; ++n) _Pragma("unroll") for (int k = 0; k < 2; ++k) \
        acc[ai][bj][m][n] = __builtin_amdgcn_mfma_f32_16x16x32_bf16(Bt[n][k], At[m][k], acc[ai][bj][m][n], 0, 0, 0); __builtin_amdgcn_s_setprio(0); } while (0)
#define PG8_WAIT_V(n) asm volatile("s_waitcnt vmcnt(" #n ")" ::: "memory")
#define PG8_WAIT_L(n) asm volatile("s_waitcnt lgkmcnt(" #n ")" ::: "memory")
#define PG8_BAR __builtin_amdgcn_s_barrier()
#define PG8_SCHED __builtin_amdgcn_sched_barrier(0)
#define PG8_KA(base, t) ((base) + (long)(t) * kstep + ((t) >= tseg ? segoff : 0L))
#define PG8_KB(base, t) ((base) + (long)(t) * kstep + ((t) >= tseg ? segoffB : 0L))
    Unit cur, nxt; int ui = 0;
    if (!uf(0, cur)) return;
    f32x4 acc[2][2][4][2];
#pragma unroll
    for (int a = 0; a < 2; ++a)
#pragma unroll
        for (int b = 0; b < 2; ++b)
#pragma unroll
            for (int m = 0; m < 4; ++m)
#pragma unroll
                for (int n = 0; n < 2; ++n) acc[a][b][m][n] = (f32x4){0.f, 0.f, 0.f, 0.f};
    bf16x8 At[4][2], B0[2][2], B1[2][2];
    const unsigned char* cA = cur.A; const unsigned char* cB = cur.B;
    PG8_STAGE(PG8_SB(0, 0), cB, voffB); PG8_STAGE(PG8_SA(0, 0), cA, voffA); PG8_STAGE(PG8_SB(0, 1), cB + hstepB, voffB); PG8_STAGE(PG8_SA(0, 1), cA + hstepA, voffA);
    if (wr == 1) PG8_BAR;
    PG8_WAIT_V(4); PG8_BAR;
    PG8_STAGE(PG8_SB(1, 0), PG8_KB(cB, 1), voffB); PG8_STAGE(PG8_SA(1, 0), PG8_KA(cA, 1), voffA); PG8_STAGE(PG8_SB(1, 1), PG8_KB(cB, 1) + hstepB, voffB);
    PG8_WAIT_V(6); PG8_BAR;
    for (;;) {
        const bool has_next = uf(ui + 1, nxt);
        const unsigned char* nA = has_next ? nxt.A : cA; const unsigned char* nB = has_next ? nxt.B : cB;
        for (int t = 0; t < nt; t += 2) {
            const bool last = (t == nt - 2);
            const unsigned char* a1 = PG8_KA(cA, t + 1);
            const unsigned char* a2 = last ? nA : PG8_KA(cA, t + 2); const unsigned char* b2 = last ? nB : PG8_KB(cB, t + 2);
            const unsigned char* a3 = last ? PG8_KA(nA, 1) : PG8_KA(cA, t + 3); const unsigned char* b3 = last ? PG8_KB(nB, 1) : PG8_KB(cB, t + 3);
            PG8_LDB(B0, 0, 0); PG8_SCHED; PG8_LDA(At, 0, 0); PG8_STAGE(PG8_SA(1, 1), a1 + hstepA, voffA);
            PG8_WAIT_L(8); PG8_BAR; PG8_WAIT_L(0); PG8_MMA(0, 0, At, B0); PG8_BAR; PG8_SCHED;
            PG8_LDB(B1, 0, 1); PG8_STAGE(PG8_SB(0, 0), b2, voffB);
            PG8_BAR; PG8_WAIT_L(0); PG8_MMA(0, 1, At, B1); PG8_BAR;
            PG8_LDA(At, 0, 1); PG8_STAGE(PG8_SA(0, 0), a2, voffA);
            PG8_BAR; PG8_WAIT_L(0); PG8_MMA(1, 0, At, B0); PG8_BAR; PG8_SCHED;
            PG8_STAGE(PG8_SB(0, 1), b2 + hstepB, voffB);
            PG8_WAIT_V(6); PG8_BAR; PG8_MMA(1, 1, At, B1); PG8_BAR;
            PG8_LDB(B0, 1, 0); PG8_SCHED; PG8_LDA(At, 1, 0); PG8_STAGE(PG8_SA(0, 1), a2 + hstepA, voffA);
            PG8_WAIT_L(8); PG8_BAR; PG8_WAIT_L(0); PG8_MMA(0, 0, At, B0); PG8_BAR; PG8_SCHED;
            PG8_LDB(B1, 1, 1); PG8_STAGE(PG8_SB(1, 0), b3, voffB);
            PG8_BAR; PG8_WAIT_L(0); PG8_MMA(0, 1, At, B1); PG8_BAR;
            PG8_LDA(At, 1, 1); PG8_STAGE(PG8_SA(1, 0), a3, voffA);
            PG8_BAR; PG8_WAIT_L(0); PG8_MMA(1, 0, At, B0); PG8_BAR; PG8_SCHED;
            PG8_STAGE(PG8_SB(1, 1), b3 + hstepB, voffB);
            PG8_WAIT_V(6); PG8_BAR; PG8_MMA(1, 1, At, B1); PG8_BAR;
        }
        E(acc, cur, wr, wc, fr, fq);
        if (!has_next) break;
#pragma unroll
        for (int a = 0; a < 2; ++a)
#pragma unroll
            for (int b = 0; b < 2; ++b)
#pragma unroll
                for (int m = 0; m < 4; ++m)
#pragma unroll
                    for (int n = 0; n < 2; ++n) acc[a][b][m][n] = (f32x4){0.f, 0.f, 0.f, 0.f};
        cur = nxt; cA = nA; cB = nB; ++ui;
    }
    PG8_WAIT_V(0);
    if (wr == 0) PG8_BAR;
    PG8_BAR;
#undef PG8_SA
#undef PG8_SB
#undef PG8_STAGE
#undef PG8_LDA
#undef PG8_LDB
#undef PG8_MMA
#undef PG8_WAIT_V
#undef PG8_WAIT_L
#undef PG8_BAR
#undef PG8_SCHED
#undef PG8_KA
#undef PG8_KB
}

struct EpiBf16 {
    __device__ __forceinline__ void operator()(const f32x4 (&acc)[2][2][4][2], const Unit& u, int wr, int wc, int fr, int fq) const {
        if (u.kind == 1) {
            if (wc < 2) {
#pragma unroll
                for (int ai = 0; ai < 2; ++ai)
#pragma unroll
                    for (int m = 0; m < 4; ++m) { float* rowp = (float*)(u.O + (size_t)(ai * 128 + wr * 64 + m * 16 + fr) * u.ldo) + wc * 32 + 8 * fq;
                        *(f32x4*)(rowp) = acc[ai][0][m][0]; *(f32x4*)(rowp + 4) = acc[ai][0][m][1]; }
            }
            return;
        }
        const bool gate = (u.kind == 2);
#pragma unroll
        for (int ai = 0; ai < 2; ++ai)
#pragma unroll
            for (int m = 0; m < 4; ++m) {
                const size_t ro = (size_t)(ai * 128 + wr * 64 + m * 16 + fr) * u.ldo + (size_t)(wc * 32 + 8 * fq) * 2;
#pragma unroll
                for (int bj = 0; bj < 2; ++bj) { f32x4 v0 = acc[ai][bj][m][0], v1 = acc[ai][bj][m][1];
                    if (gate) { const u32x4 z = *(const u32x4*)(u.X + ro + bj * 256);
                        v0[0] *= u.scale * silu_f(bflo(z.x)); v0[1] *= u.scale * silu_f(bfhi(z.x)); v0[2] *= u.scale * silu_f(bflo(z.y)); v0[3] *= u.scale * silu_f(bfhi(z.y));
                        v1[0] *= u.scale * silu_f(bflo(z.z)); v1[1] *= u.scale * silu_f(bfhi(z.z)); v1[2] *= u.scale * silu_f(bflo(z.w)); v1[3] *= u.scale * silu_f(bfhi(z.w)); }
                    u32x4 w; w.x = cvt_pk(v0[0], v0[1]); w.y = cvt_pk(v0[2], v0[3]); w.z = cvt_pk(v1[0], v1[1]); w.w = cvt_pk(v1[2], v1[3]);
                    *(u32x4*)(u.O + ro + bj * 256) = w; }
            }
    }
};
template <bool HALF> struct EpiResT {
    __device__ __forceinline__ void operator()(const f32x4 (&acc)[2][2][4][2], const Unit& u, int wr, int wc, int fr, int fq) const {
        f32x4 gv[2][2];
#pragma unroll
        for (int bj = 0; bj < 2; ++bj)
#pragma unroll
            for (int n = 0; n < 2; ++n) gv[bj][n] = *(const f32x4*)(u.G + bj * 128 + wc * 32 + n * 16 + 4 * fq);
#pragma unroll
        for (int ai = 0; ai < (HALF ? 1 : 2); ++ai)
#pragma unroll
            for (int m = 0; m < 4; ++m) {
                const size_t ro = (size_t)(ai * 128 + wr * 64 + m * 16 + fr) * 4096 + (size_t)(wc * 32 + 4 * fq) * 4;
#pragma unroll
                for (int bj = 0; bj < 2; ++bj)
#pragma unroll
                    for (int n = 0; n < 2; ++n) { const size_t o = ro + (size_t)(bj * 128 + n * 16) * 4;
                        const f32x4 xo = *(const f32x4*)(u.X + o); *(f32x4*)(u.O + o) = xo + gv[bj][n] * acc[ai][bj][m][n]; }
            }
    }
};

typedef EpiResT<false> EpiRes;
__device__ void phase_prep0(const P& p, unsigned char* sm) {
    const int tid = otid(), G = gridDim.x, bid = blockIdx.x;
    float* sact = (float*)sm; float* red = sact + 9 * 1024;
    for (int i = tid; i < 9 * 1024; i += 512) { const int ci = i >> 10, k = i & 1023; const float v = ci == 0 ? p.c_ctx[k] : p.c[(ci - 1) * 1024 + k]; sact[i] = silu_f(v); }
    __syncthreads();
    float* MOD = (float*)(p.ws + WS_MOD);
    for (int u = bid; u < 192; u += G) {
        const int layer = u / 48, cb = u % 48, kq = tid >> 6, cl = tid & 63, col = cb * 64 + cl;
        float a0 = 0, a1 = 0, a2 = 0, a3 = 0, a4 = 0, a5 = 0, a6 = 0, a7 = 0, a8 = 0;
        const float* w = p.w_mod + ((size_t)layer * 1024 + kq * 128) * 3072 + col; const float* sa = sact + kq * 128;
#pragma unroll 16
        for (int k = 0; k < 128; ++k) { const float wv = w[(size_t)k * 3072];
            a0 += sa[k] * wv; a1 += sa[1024 + k] * wv; a2 += sa[2048 + k] * wv; a3 += sa[3072 + k] * wv; a4 += sa[4096 + k] * wv;
            a5 += sa[5120 + k] * wv; a6 += sa[6144 + k] * wv; a7 += sa[7168 + k] * wv; a8 += sa[8192 + k] * wv; }
        float* rr = red + kq * 576 + cl;
        rr[0] = a0; rr[64] = a1; rr[128] = a2; rr[192] = a3; rr[256] = a4; rr[320] = a5; rr[384] = a6; rr[448] = a7; rr[512] = a8;
        __syncthreads();
        for (int o = tid; o < 576; o += 512) { const int ci = o >> 6, c2 = cb * 64 + (o & 63); float s = 0;
            for (int q = 0; q < 8; ++q) s += red[q * 576 + o];
            MOD[(ci * 4 + layer) * 3072 + c2] = s + p.b_mod[layer * 3072 + c2]; }
        __syncthreads();
    }
    const long gt = (long)bid * 512 + tid, gn = (long)G * 512;
    const float TWO_PI = 6.283185307179586f;
    for (long i = gt; i < 512 * 256 / 8; i += gn) { const int j = (int)(i >> 5), c0 = (int)(i & 31) * 8, m = j >> 1, part = j & 1; float v[8];
#pragma unroll
        for (int e = 0; e < 8; ++e) { const float ang = (float)((m * (c0 + e)) & 255) * (TWO_PI / 256.f); v[e] = j == 1 ? (((c0 + e) & 1) ? -1.f : 1.f) : (part ? -__sinf(ang) : __cosf(ang)); }
        u32x4 w; w.x = cvt_pk(v[0], v[1]); w.y = cvt_pk(v[2], v[3]); w.z = cvt_pk(v[4], v[5]); w.w = cvt_pk(v[6], v[7]);
        *(u32x4*)(p.ws + WS_TC + (size_t)i * 16) = w; }
    for (long i = gt; i < 256 * 512 / 8; i += gn) { const int k = (int)(i >> 6), kk0 = (int)(i & 63) * 8, part = kk0 >> 8, l0 = kk0 & 255; float v[8];
#pragma unroll
        for (int e = 0; e < 8; ++e) { const float ang = (float)((k * (l0 + e)) & 255) * (TWO_PI / 256.f); v[e] = part ? __sinf(ang) : __cosf(ang); }
        u32x4 w; w.x = cvt_pk(v[0], v[1]); w.y = cvt_pk(v[2], v[3]); w.z = cvt_pk(v[4], v[5]); w.w = cvt_pk(v[6], v[7]);
        *(u32x4*)(p.ws + WS_ALC + (size_t)i * 16) = w; }
    for (long i = gt; i < 2048L * 2048 / 8; i += gn) { const int k = (int)(i >> 8), kk0 = (int)(i & 255) * 8, part = kk0 >> 10, l0 = kk0 & 1023; float v[8];
#pragma unroll
        for (int e = 0; e < 8; ++e) { const int l = l0 + e; const float ang = (float)((k * l) & 2047) * (TWO_PI / 2048.f);
            v[e] = part ? (l == 0 ? ((k & 1) ? -1.f : 1.f) : __sinf(ang)) : __cosf(ang); }
        u32x4 w; w.x = cvt_pk(v[0], v[1]); w.y = cvt_pk(v[2], v[3]); w.z = cvt_pk(v[4], v[5]); w.w = cvt_pk(v[6], v[7]);
        *(u32x4*)(slot_ptr(p, k >> 9, 1) + ((size_t)(k & 511) * 2048 + kk0) * 2) = w; }
    for (long i = gt; i < 2L * 1024 * 1024 / 8; i += gn) { const int e = (int)(i >> 17), d = (int)(i >> 7) & 1023, c0 = (int)(i & 127) * 8;
        const float* src = p.fc_w_in + ((size_t)e * 1024 + d) * 6144 + c0; const f32x4 x0 = *(const f32x4*)src, x1 = *(const f32x4*)(src + 4);
        u32x4 w; w.x = cvt_pk(x0[0], x0[1]); w.y = cvt_pk(x0[2], x0[3]); w.z = cvt_pk(x1[0], x1[1]); w.w = cvt_pk(x1[2], x1[3]);
        *(u32x4*)(p.ws + WS_WUBF + (size_t)i * 16) = w; }
}

struct UF_Prep1 { unsigned char* ws; int G, c;
    __device__ __forceinline__ bool operator()(int i, Unit& u) const { const int L = i * G + c; if (L >= 64) return false;
        const int e = L >> 5, g = (L >> 3) & 3, pm = (L >> 2) & 1, pn = L & 3;
        u.A = ws + WS_TC + (size_t)pm * 256 * 512; u.B = ws + WS_WUBF + (((size_t)e * 1024 + pn * 256) * 1024 + g * 256) * 2;
        u.O = ws + WS_WF + (((size_t)e * 2048 + g * 512 + pm * 256) * 1024 + pn * 256) * 2; u.ldo = 2048; u.kind = 0; u.X = nullptr; u.G = nullptr; u.scale = 1.f; return true; } };

template <class RowPtr>
__device__ __forceinline__ void conv_tiles4(const float* W, int ldw, int k0, int n0, int nvalid  , const RowPtr& rowptr, float* sT) {
    const int tid = otid();
#pragma unroll
    for (int j = 0; j < 4; ++j)
#pragma unroll
        for (int i = 0; i < 8; ++i) { const int e = tid + i * 512, kk = e >> 6, nn = e & 63, n = n0 + j * 64 + nn;
            sT[j * 4160 + kk * 65 + nn] = n < nvalid ? W[(size_t)(k0 + kk) * ldw + n] : 0.f; }
    __syncthreads();
    { const int nn = tid >> 3, kc = (tid & 7) * 8;
#pragma unroll
      for (int j = 0; j < 4; ++j) { float v[8];
#pragma unroll
          for (int i = 0; i < 8; ++i) v[i] = sT[j * 4160 + (kc + i) * 65 + nn];
          u32x4 w; w.x = cvt_pk(v[0], v[1]); w.y = cvt_pk(v[2], v[3]); w.z = cvt_pk(v[4], v[5]); w.w = cvt_pk(v[6], v[7]);
          *(u32x4*)(rowptr(n0 + j * 64 + nn) + (size_t)(k0 + kc) * 2) = w; } }
    __syncthreads();
}

__device__ void norm_rows(const P& p, int layer, int tok_lo, int ntok, unsigned char* hm) {
    const int tid = otid(), lane = tid & 63, gw = blockIdx.x * 8 + (tid >> 6), nw = gridDim.x * 8;
    const float* MOD = (const float*)(p.ws + WS_MOD);
    const float* ng = p.norm_g + layer * 1024;
    const int rpw = (ntok + nw - 1) / nw, r_lo = gw * rpw, r_hi = r_lo + rpw < ntok ? r_lo + rpw : ntok;
    f32x4 gs[4], shv[4]; int cur_cond = -1;
#pragma unroll
    for (int i = 0; i < 4; ++i) { gs[i] = (f32x4){0.f, 0.f, 0.f, 0.f}; shv[i] = gs[i]; }
    for (int t0 = r_lo; t0 < r_hi; t0 += 4) {
        f32x4 v[4][4]; float ss[4];
#pragma unroll
        for (int j = 0; j < 4; ++j) { const int t = t0 + j < r_hi ? t0 + j : r_hi - 1, tok = tok_lo + t;
            const float* xr = layer == 0 ? (tok < TOKC ? p.x_prompt + (size_t)tok * 1024 : p.x_sample + (size_t)(tok - TOKC) * 1024) : p.out + (size_t)tok * 1024;
#pragma unroll
            for (int i = 0; i < 4; ++i) v[j][i] = *(const f32x4*)(xr + i * 256 + lane * 4); }
#pragma unroll
        for (int j = 0; j < 4; ++j) { float a = 0.f;
#pragma unroll
            for (int i = 0; i < 4; ++i) a += v[j][i][0] * v[j][i][0] + v[j][i][1] * v[j][i][1] + v[j][i][2] * v[j][i][2] + v[j][i][3] * v[j][i][3];
            ss[j] = a; }
#pragma unroll
        for (int o = 32; o >= 1; o >>= 1) {
#pragma unroll
            for (int j = 0; j < 4; ++j) ss[j] += __shfl_xor(ss[j], o); }
#pragma unroll
        for (int j = 0; j < 4; ++j) if (t0 + j < r_hi) { const int t = t0 + j, tok = tok_lo + t;
            const float rstd = rsqrtf(ss[j] * (1.0f / 1024.f) + 1e-6f);
            const int cond = cond_of_tok(tok);
            if (cond != cur_cond) { cur_cond = cond; const float* md = MOD + (size_t)(cond * 4 + layer) * 3072;
#pragma unroll
                for (int i = 0; i < 4; ++i) { const int col = i * 256 + lane * 4; const f32x4 g = *(const f32x4*)(ng + col), sc = *(const f32x4*)(md + 1024 + col);
                    shv[i] = *(const f32x4*)(md + col);
#pragma unroll
                    for (int e = 0; e < 4; ++e) gs[i][e] = g[e] * (1.0f + sc[e]); } }
#pragma unroll
            for (int i = 0; i < 4; ++i) { const int col = i * 256 + lane * 4; f32x4 y;
#pragma unroll
                for (int e = 0; e < 4; ++e) y[e] = (v[j][i][e] * rstd) * gs[i][e] + shv[i][e];
                u32x2 w; w.x = cvt_pk(y[0], y[1]); w.y = cvt_pk(y[2], y[3]);
                *(u32x2*)(hm + ((size_t)t * 1024 + col) * 2) = w; } }
    }
}

__device__ void conv_even(const P& p, unsigned char* sm, int layer, int rank, int nblk) {
    const int e = layer >> 1;
    {
        float* sT = (float*)sm;
        const P* pp = &p;
        for (int t = rank; t < 320 + 128; t += nblk) {
            if (t < 320) { const int kt = t & 15, n0 = (t >> 4) * 256;
                conv_tiles4(p.fc_w_in + (size_t)e * 1024 * 6144 + 1024, 6144, kt * 64, n0, 5120, [pp](int n) { return slot_ptr(*pp, 8 + (n >> 10), 1) + (size_t)(n & 1023) * 2048; }, sT);
            } else { const int t2 = t - 320, kt = t2 & 31, n0 = (t2 >> 5) * 256;
                conv_tiles4(p.fc_w_out + (size_t)e * 2048 * 1024, 1024, kt * 64, n0, 1024, [pp](int n) { return slot_ptr(*pp, 13 + (n >> 9), 1) + (size_t)(n & 511) * 4096; }, sT); }
        }
    }
}
__device__ void phase_normE(const P& p, unsigned char* sm, int layer, int pass) {
    if (pass == 0 && layer == 0) conv_even(p, sm, layer, blockIdx.x, gridDim.x);
    norm_rows(p, layer, pass ? E_T0 * 256 : 0, (pass ? E_T1 : E_T0) * 256, p.ws + E_HM);
}
struct UF_G1E { const P* p; int e, pass, G, c;
    __device__ __forceinline__ bool operator()(int i, Unit& u) const { int L = i * G + c; const int nt = pass ? E_T1 : E_T0, t0 = pass ? E_T0 : 0; if (L >= nt * 24) return false;
        unsigned char* ws = p->ws; int pm, pn; u.kind = 0; u.X = nullptr; u.G = nullptr; u.scale = 1.f;
        if (L < nt * 20) { tile_order(L, nt, 20, pm, pn);
            u.A = ws + E_HM + (size_t)pm * 256 * 2048; u.B = slot_ptr(*p, 8 + (pn >> 2), 1) + (size_t)(pn & 3) * 256 * 2048; u.ldo = 2048;
            if (pn < 4) u.O = ws + E_ZA + (((size_t)(t0 + pm) * 256) * 1024 + pn * 256) * 2;
            else u.O = ws + E_PL + (size_t)((pn - 4) >> 2) * E_PS + ((size_t)pm * 256 * 1024 + (pn & 3) * 256) * 2;
        } else { L -= nt * 20; tile_order(L, 4, nt, pm, pn);
            u.A = ws + WS_WF + ((size_t)e * 2048 + pm * 512) * 2048; u.B = ws + E_HM + (size_t)pn * 256 * 2048;
            const int g = pm, j0 = 0, tg = t0 + pn;
            if (tg < 16) { u.O = ws + E_VTC + (((size_t)(tg * 4 + g) * 512 + j0) * 256) * 2; u.ldo = 512; }
            else { const int t2 = tg - 16, b = t2 >> 3, l0 = (t2 & 7) * 256; u.O = ws + E_VTL + (((size_t)(b * 4 + g) * 512 + j0) * 2048 + l0) * 2; u.ldo = 4096; }
        }
        return true; } };
__device__ __forceinline__ void up8(const u32x4 a, const u32x4 b, float (&o)[8]) {
    o[0] = bflo(a.x) * bflo(b.x); o[1] = bfhi(a.x) * bfhi(b.x); o[2] = bflo(a.y) * bflo(b.y); o[3] = bfhi(a.y) * bfhi(b.y);
    o[4] = bflo(a.z) * bflo(b.z); o[5] = bfhi(a.z) * bfhi(b.z); o[6] = bflo(a.w) * bflo(b.w); o[7] = bfhi(a.w) * bfhi(b.w); }
__device__ void phase_e3(const P& p, int layer, int pass) {
    const int e = layer >> 1;
    const long gt = (long)blockIdx.x * 512 + otid(), gn = (long)gridDim.x * 512;
    const unsigned char* PL = p.ws + E_PL; const size_t PS = E_PS; const int tok_lo = pass ? E_T0 * 256 : 0, nstrip = (pass ? E_T1 : E_T0) * 64;
    const float* cw = p.fc_conv_w + (size_t)e * 3 * 1024;
    for (long it = gt; it < (long)nstrip * 128; it += gn) {
        const int tl = (int)(it >> 7) * 4, c8 = (int)(it & 127) * 8, tok = tok_lo + tl;
        const int rl = tok < TOKC ? 256 : 64, pos = tok & (rl - 1);
        const size_t o = ((size_t)tl * 1024 + c8) * 2;
        float cv[6][8];
        const u32x4 zero = {0, 0, 0, 0};
#pragma unroll
        for (int j = 0; j < 6; ++j) { const bool ok = (j == 0) ? (pos > 0) : (j == 5 ? (pos + 4 < rl) : true);
            const u32x4 cc = ok ? *(const u32x4*)(PL + PS + o + (long)(j - 1) * 2048) : zero, vv = ok ? *(const u32x4*)(PL + 2 * PS + o + (long)(j - 1) * 2048) : zero;
            up8(cc, vv, cv[j]); }
        float w0[8], w1[8], w2[8];
        { const f32x4 a0 = *(const f32x4*)(cw + c8), a1 = *(const f32x4*)(cw + c8 + 4), b0 = *(const f32x4*)(cw + 1024 + c8), b1 = *(const f32x4*)(cw + 1024 + c8 + 4),
                      c0 = *(const f32x4*)(cw + 2048 + c8), c1 = *(const f32x4*)(cw + 2048 + c8 + 4);
#pragma unroll
          for (int j = 0; j < 4; ++j) { w0[j] = a0[j]; w0[4 + j] = a1[j]; w1[j] = b0[j]; w1[4 + j] = b1[j]; w2[j] = c0[j]; w2[4 + j] = c1[j]; } }
#pragma unroll
        for (int t = 0; t < 4; ++t) {
            const u32x4 bv = *(const u32x4*)(PL + o + (size_t)t * 2048), zv = *(const u32x4*)(PL + 3 * PS + o + (size_t)t * 2048);
            float bz[8];
            bz[0] = bflo(bv.x) * silu_f(bflo(zv.x)); bz[1] = bfhi(bv.x) * silu_f(bfhi(zv.x)); bz[2] = bflo(bv.y) * silu_f(bflo(zv.y)); bz[3] = bfhi(bv.y) * silu_f(bfhi(zv.y));
            bz[4] = bflo(bv.z) * silu_f(bflo(zv.z)); bz[5] = bfhi(bv.z) * silu_f(bfhi(zv.z)); bz[6] = bflo(bv.w) * silu_f(bflo(zv.w)); bz[7] = bfhi(bv.w) * silu_f(bfhi(zv.w));
            float r[8];
#pragma unroll
            for (int j = 0; j < 8; ++j) r[j] = bz[j] * (w0[j] * cv[t][j] + w1[j] * cv[t + 1][j] + w2[j] * cv[t + 2][j]);
            u32x4 w; w.x = cvt_pk(r[0], r[1]); w.y = cvt_pk(r[2], r[3]); w.z = cvt_pk(r[4], r[5]); w.w = cvt_pk(r[6], r[7]);
            *(u32x4*)(p.ws + E_YB + ((size_t)(tok + t) * 1024 + c8) * 2) = w;
        }
    }
    if (pass == 1) {
        unsigned short* VT = (unsigned short*)(p.ws + E_VTL);
        for (long it = gt; it < 32L * 128 * 128; it += gn) {
            const int l0 = (int)(it & 127) * 8, m = (int)(it >> 7) & 127; const long slice = it >> 14;
            unsigned short* base = VT + (size_t)slice * 512 * 2048;
            unsigned short* vr = base + (size_t)(2 * m) * 2048; unsigned short* vi = vr + 2048;
            const u32x4 a = *(const u32x4*)(vr + l0), b = *(const u32x4*)(vi + l0);
            const u32x4 ma = *(const u32x4*)(vr + 2040 - l0), mb = *(const u32x4*)(vi + 2040 - l0);
            float x0r, x0i;
            if (l0 == 0) { x0r = 0.f; x0i = 0.f; } else { x0r = bf2f((short)vr[2048 - l0]); x0i = bf2f((short)vi[2048 - l0]); }
            const float ny_r = bf2f((short)vr[1024]), ny_i = bf2f((short)vi[1024]);
            float er[8], eo[8];
            float es[8];
            er[0] = bflo(a.x) + x0r;        eo[0] = bflo(b.x) - x0i;        es[0] = bflo(b.x) + x0i;
            er[1] = bfhi(a.x) + bfhi(ma.w); eo[1] = bfhi(b.x) - bfhi(mb.w); es[1] = bfhi(b.x) + bfhi(mb.w);
            er[2] = bflo(a.y) + bflo(ma.w); eo[2] = bflo(b.y) - bflo(mb.w); es[2] = bflo(b.y) + bflo(mb.w);
            er[3] = bfhi(a.y) + bfhi(ma.z); eo[3] = bfhi(b.y) - bfhi(mb.z); es[3] = bfhi(b.y) + bfhi(mb.z);
            er[4] = bflo(a.z) + bflo(ma.z); eo[4] = bflo(b.z) - bflo(mb.z); es[4] = bflo(b.z) + bflo(mb.z);
            er[5] = bfhi(a.z) + bfhi(ma.y); eo[5] = bfhi(b.z) - bfhi(mb.y); es[5] = bfhi(b.z) + bfhi(mb.y);
            er[6] = bflo(a.w) + bflo(ma.y); eo[6] = bflo(b.w) - bflo(mb.y); es[6] = bflo(b.w) + bflo(mb.y);
            er[7] = bfhi(a.w) + bfhi(ma.x); eo[7] = bfhi(b.w) - bfhi(mb.x); es[7] = bfhi(b.w) + bfhi(mb.x);
            u32x4 w; w.x = cvt_pk(er[0], er[1]); w.y = cvt_pk(er[2], er[3]); w.z = cvt_pk(er[4], er[5]); w.w = cvt_pk(er[6], er[7]);
            if (m != 0) {
                if (l0 == 0) eo[0] = ny_r;
                u32x4 z; z.x = cvt_pk(eo[0], eo[1]); z.y = cvt_pk(eo[2], eo[3]); z.z = cvt_pk(eo[4], eo[5]); z.w = cvt_pk(eo[6], eo[7]);
                u32x4 zn; zn.x = cvt_pk(l0 == 0 ? ny_r : -eo[0], -eo[1]); zn.y = cvt_pk(-eo[2], -eo[3]); zn.z = cvt_pk(-eo[4], -eo[5]); zn.w = cvt_pk(-eo[6], -eo[7]);
                *(u32x4*)(vr + l0) = w; *(u32x4*)(vi + l0) = z;
                unsigned short* wr = base + (size_t)(2 * (256 - m)) * 2048;
                *(u32x4*)(wr + l0) = w; *(u32x4*)(wr + 2048 + l0) = zn;
            } else {
                u32x4 z0 = {0u, 0u, 0u, 0u}, z128 = {0u, 0u, 0u, 0u};
                if (l0 == 0) { z0.x = cvt_pk(ny_r, 0.f); z128.x = cvt_pk(ny_i, 0.f); es[0] = bflo(b.x); }
                u32x4 w128; w128.x = cvt_pk(es[0], es[1]); w128.y = cvt_pk(es[2], es[3]); w128.z = cvt_pk(es[4], es[5]); w128.w = cvt_pk(es[6], es[7]);
                *(u32x4*)(vr + l0) = w; *(u32x4*)(vi + l0) = z0;
                unsigned short* wr = base + (size_t)256 * 2048;
                *(u32x4*)(wr + l0) = w128; *(u32x4*)(wr + 2048 + l0) = z128;
            }
        }
        unsigned short* VC = (unsigned short*)(p.ws + E_VTC);
        for (long it = gt; it < 64L * 128 * 32; it += gn) {
            const int l0 = (int)(it & 31) * 8, m = (int)(it >> 5) & 127; const long slice = it >> 12;
            unsigned short* base = VC + (size_t)slice * 512 * 256;
            const u32x4 a = *(const u32x4*)(base + (size_t)(2 * m) * 256 + l0), b = *(const u32x4*)(base + (size_t)(2 * m + 1) * 256 + l0);
            if (m != 0) { u32x4 bn; bn.x = b.x ^ 0x80008000u; bn.y = b.y ^ 0x80008000u; bn.z = b.z ^ 0x80008000u; bn.w = b.w ^ 0x80008000u;
                unsigned short* wr = base + (size_t)(2 * (256 - m)) * 256; *(u32x4*)(wr + l0) = a; *(u32x4*)(wr + 256 + l0) = bn;
            } else { const u32x4 z = {0u, 0u, 0u, 0u};
                unsigned short* wr = base + (size_t)256 * 256; *(u32x4*)(wr + l0) = b; *(u32x4*)(wr + 256 + l0) = z; *(u32x4*)(base + 256 + l0) = z; }
        }
    }
}
struct UF_E4L { const P* p; int G, c;
    __device__ __forceinline__ bool operator()(int i, Unit& u) const { const int L = i * G + c; if (L >= 256) return false;
        const int xcd = L & 7, j = L >> 3, sl = xcd + 8 * (j >> 3), pm = j & 7, g = sl & 3, b = sl >> 2; unsigned char* ws = p->ws;
        u.A = slot_ptr(*p, pm >> 1, 1) + (size_t)(pm & 1) * 256 * 4096; u.B = ws + E_VTL + (size_t)(b * 4 + g) * 512 * 2048 * 2;
        const size_t o = (((size_t)TOKC + b * 2048 + pm * 256) * 1024 + g * 256) * 2;
        u.O = ws + E_YA + o; u.X = ws + E_ZA + o; u.ldo = 2048; u.kind = 2; u.G = nullptr; u.scale = 0.0013810679320049757f; return true; } };
struct UF_E4C { const P* p; int G, c;
    __device__ __forceinline__ bool operator()(int i, Unit& u) const { const int L = i * G + c; if (L >= 64) return false;
        const int g = L & 3, b = L >> 2; unsigned char* ws = p->ws;
        u.A = ws + WS_ALC; u.B = ws + E_VTC + (size_t)(b * 4 + g) * 512 * 256 * 2;
        const size_t o = (((size_t)b * 256) * 1024 + g * 256) * 2;
        u.O = ws + E_YA + o; u.X = ws + E_ZA + o; u.ldo = 2048; u.kind = 2; u.G = nullptr; u.scale = 0.00390625f; return true; } };
struct UF_G2 { const P* p; int layer, sub, G, c;
    __device__ __forceinline__ bool operator()(int i, Unit& u) const { const int L = i * G + c; int pm, pn, row0;
        if (sub == 0) { if (L >= 256) return false; tile_order(L, 64, 4, pm, pn); row0 = pm * 256; }
        else { if (L >= 128) return false; tile_order(L, 32, 4, pm, pn); row0 = 16384 + pm * 128; }
        unsigned char* ws = p->ws; const bool even = (layer & 1) == 0;
        if (even) { u.A = ws + E_YA + (size_t)row0 * 2048; u.B = slot_ptr(*p, 13 + (pn >> 1), 1) + (size_t)(pn & 1) * 256 * 4096; }
        else { u.A = ws + O_YN + (size_t)row0 * 4096; u.B = ws + O_WOUT + (size_t)pn * 256 * 4096; }
        const size_t o = ((size_t)row0 * 1024 + pn * 256);
        u.O = (unsigned char*)(p->out + o);
        u.X = layer == 0 ? (const unsigned char*)((row0 < TOKC ? p->x_prompt + (size_t)row0 * 1024 : p->x_sample + (size_t)(row0 - TOKC) * 1024) + pn * 256) : (const unsigned char*)(p->out + o);
        u.G = (const float*)(ws + WS_MOD) + (size_t)(cond_of_tok(row0) * 4 + layer) * 3072 + 2048 + pn * 256;
        u.ldo = 4096; u.kind = 0; u.scale = 1.f; return true; } };

__device__ void conv_odd(const P& p, unsigned char* sm, int layer, int rank, int nblk) {
    const int li = layer >> 1; float* sT = (float*)sm; unsigned char* ws = p.ws;
    for (int t = rank; t < 400 + 128; t += nblk) {
        if (t < 400) { const int kt = t & 15, n0 = (t >> 4) * 256;
            conv_tiles4(p.ssd_w_in + (size_t)li * 1024 * 6208, 6208, kt * 64, n0, 6208, [ws](int n) { return ws + O_WIN + (size_t)n * 2048; }, sT);
        } else { const int t2 = t - 400, kt = t2 & 31, n0 = (t2 >> 5) * 256;
            conv_tiles4(p.ssd_w_out + (size_t)li * 2048 * 1024, 1024, kt * 64, n0, 1024, [ws](int n) { return ws + O_WOUT + (size_t)n * 4096; }, sT); }
    }
}
__device__ void phase_normO(const P& p, unsigned char* sm, int layer) {
    norm_rows(p, layer, 0, TOK, p.ws + O_HM);
}
struct UF_G1O { unsigned char* ws; int pass, nq, G, c;
    __device__ __forceinline__ bool operator()(int i, Unit& u) const { const int L = i * G + c; if (L >= 80 * nq) return false;
        int pm, q; tile_order(L, 80, nq, pm, q); u.kind = 0; u.X = nullptr; u.G = nullptr; u.scale = 1.f;
        u.A = ws + O_HM + (size_t)pm * 256 * 2048;
        int nrow;
        if (q < 2) { nrow = 512 * pass + 256 * q; u.O = ws + O_Z + ((size_t)pm * 256 * 512 + q * 256) * 2; u.ldo = 1024; }
        else if (q < 4) { nrow = 2048 + 512 * pass + 256 * (q - 2); u.O = ws + O_RAWX + ((size_t)pm * 256 * 512 + (q - 2) * 256) * 2; u.ldo = 1024; }
        else if (q == 4) { nrow = 4096 + 256 * pass; u.O = ws + O_RAWB + (size_t)pm * 256 * 256 * 2; u.ldo = 512; }
        else if (q == 5) { nrow = 5120 + 256 * pass; u.O = ws + O_RAWC + (size_t)pm * 256 * 256 * 2; u.ldo = 512; }
        else { nrow = 6144; u.O = ws + O_DTR + (size_t)pm * 256 * 64 * 4; u.ldo = 256; u.kind = 1; }
        u.B = ws + O_WIN + (size_t)nrow * 2048; return true; } };

struct O3Tile { const unsigned char* src; unsigned char* dstN; unsigned char* dstT; int lds_, cch, ch0, ldn; };
__device__ __forceinline__ O3Tile o3_decode(unsigned char* ws, int ct, int pass) {
    O3Tile t; t.dstN = nullptr; t.dstT = nullptr; t.ldn = 512;
    if (ct < 8) { t.ch0 = ct * 64; t.src = ws + O_RAWX; t.lds_ = 1024; t.cch = 512 * pass + t.ch0; t.dstN = ws + O_XT; t.ldn = 1024; }
    else if (ct < 12) { t.ch0 = (ct - 8) * 64; t.src = ws + O_RAWB; t.lds_ = 512; t.cch = 2048 + 256 * pass + t.ch0; t.dstN = ws + O_BS; }
    else { t.ch0 = (ct - 12) * 64; t.src = ws + O_RAWC; t.lds_ = 512; t.cch = 3072 + 256 * pass + t.ch0; t.dstN = ws + O_CS; }
    return t;
}
__device__ __forceinline__ void o3_load(const O3Tile& t, int tok, int c8, u32x4& x0, u32x4& xm, u32x4& xp) {
    const int L = tok < TOKC ? 256 : 2048, pos = tok < TOKC ? (tok & 255) : ((tok - TOKC) & 2047);
    const unsigned char* sp = t.src + (size_t)tok * t.lds_ + (size_t)(t.ch0 + c8) * 2;
    x0 = *(const u32x4*)sp; xm = (u32x4){0, 0, 0, 0}; xp = (u32x4){0, 0, 0, 0};
    if (pos > 0) xm = *(const u32x4*)(sp - t.lds_);
    if (pos < L - 1) xp = *(const u32x4*)(sp + t.lds_);
}
__device__ void phase_o3(const P& p, unsigned char* sm, int layer, int pass) {
    const int li = layer >> 1, tid = otid();
    unsigned short* sT = (unsigned short*)sm;
    const float* cw = p.ssd_conv_w + (size_t)li * 3 * 4096; const float* cb = p.ssd_conv_b + (size_t)li * 4096;
    const int tl = tid >> 3, c8 = (tid & 7) * 8;
    int t = blockIdx.x; if (t >= 5120) return;
    int cur_ct = -1; f32x4 w0a, w0b, w1a, w1b, w2a, w2b, ba, bb; O3Tile T;
    u32x4 x0, xm, xp;
    { const O3Tile T0 = o3_decode(p.ws, t & 15, pass); o3_load(T0, (t >> 4) * 64 + tl, c8, x0, xm, xp); }
    for (; t < 5120; t += gridDim.x) {
        const int tt = t >> 4, ct = t & 15, tok = tt * 64 + tl;
        if (ct != cur_ct) { cur_ct = ct; T = o3_decode(p.ws, ct, pass); const int cc = T.cch + c8;
            w0a = *(const f32x4*)(cw + cc); w0b = *(const f32x4*)(cw + cc + 4); w1a = *(const f32x4*)(cw + 4096 + cc); w1b = *(const f32x4*)(cw + 4096 + cc + 4);
            w2a = *(const f32x4*)(cw + 8192 + cc); w2b = *(const f32x4*)(cw + 8192 + cc + 4); ba = *(const f32x4*)(cb + cc); bb = *(const f32x4*)(cb + cc + 4); }
        u32x4 n0 = x0, nm = xm, np = xp;
        { const int tn = t + gridDim.x; if (tn < 5120) { const O3Tile TN = o3_decode(p.ws, tn & 15, pass); o3_load(TN, (tn >> 4) * 64 + tl, c8, n0, nm, np); } }
        float r[8];
        r[0] = silu_f(w0a[0] * bflo(xm.x) + w1a[0] * bflo(x0.x) + w2a[0] * bflo(xp.x) + ba[0]);
        r[1] = silu_f(w0a[1] * bfhi(xm.x) + w1a[1] * bfhi(x0.x) + w2a[1] * bfhi(xp.x) + ba[1]);
        r[2] = silu_f(w0a[2] * bflo(xm.y) + w1a[2] * bflo(x0.y) + w2a[2] * bflo(xp.y) + ba[2]);
        r[3] = silu_f(w0a[3] * bfhi(xm.y) + w1a[3] * bfhi(x0.y) + w2a[3] * bfhi(xp.y) + ba[3]);
        r[4] = silu_f(w0b[0] * bflo(xm.z) + w1b[0] * bflo(x0.z) + w2b[0] * bflo(xp.z) + bb[0]);
        r[5] = silu_f(w0b[1] * bfhi(xm.z) + w1b[1] * bfhi(x0.z) + w2b[1] * bfhi(xp.z) + bb[1]);
        r[6] = silu_f(w0b[2] * bflo(xm.w) + w1b[2] * bflo(x0.w) + w2b[2] * bflo(xp.w) + bb[2]);
        r[7] = silu_f(w0b[3] * bfhi(xm.w) + w1b[3] * bfhi(x0.w) + w2b[3] * bfhi(xp.w) + bb[3]);
        u32x4 w; w.x = cvt_pk(r[0], r[1]); w.y = cvt_pk(r[2], r[3]); w.z = cvt_pk(r[4], r[5]); w.w = cvt_pk(r[6], r[7]);
        if (T.dstN) *(u32x4*)(T.dstN + (size_t)tok * T.ldn + (size_t)(T.ch0 + c8) * 2) = w;
        if (T.dstT) {
            unsigned* s32 = (unsigned*)(sT + tl * 66 + c8);
            s32[0] = w.x; s32[1] = w.y; s32[2] = w.z; s32[3] = w.w;
            __syncthreads();
            const int ch = tid >> 3, tg = tid & 7; unsigned short q[8];
#pragma unroll
            for (int i = 0; i < 8; ++i) q[i] = sT[(tg * 8 + i) * 66 + ch];
            u32x4 o; o.x = q[0] | ((unsigned)q[1] << 16); o.y = q[2] | ((unsigned)q[3] << 16); o.z = q[4] | ((unsigned)q[5] << 16); o.w = q[6] | ((unsigned)q[7] << 16);
            *(u32x4*)(T.dstT + ((size_t)(T.ch0 + ch) * TOK + tt * 64 + tg * 8) * 2) = o;
            __syncthreads();
        }
        x0 = n0; xm = nm; xp = np;
    }
}

struct ConvW { f32x4 w0a, w0b, w1a, w1b, w2a, w2b, ba, bb; };
__device__ __forceinline__ ConvW conv_w(const float* cw, const float* cb, int cc) { ConvW w;
    w.w0a = *(const f32x4*)(cw + cc); w.w0b = *(const f32x4*)(cw + cc + 4); w.w1a = *(const f32x4*)(cw + 4096 + cc); w.w1b = *(const f32x4*)(cw + 4096 + cc + 4);
    w.w2a = *(const f32x4*)(cw + 8192 + cc); w.w2b = *(const f32x4*)(cw + 8192 + cc + 4); w.ba = *(const f32x4*)(cb + cc); w.bb = *(const f32x4*)(cb + cc + 4); return w; }
__device__ __forceinline__ u32x4 conv8(const unsigned char* src, int ldsb, int tok, int col, const ConvW& W) {
    const int L = tok < TOKC ? 256 : 2048, pos = tok < TOKC ? (tok & 255) : ((tok - TOKC) & 2047);
    const unsigned char* sp = src + (size_t)tok * ldsb + (size_t)col * 2;
    const u32x4 x0 = *(const u32x4*)sp; u32x4 xm = {0, 0, 0, 0}, xp = {0, 0, 0, 0};
    if (pos > 0) xm = *(const u32x4*)(sp - ldsb);
    if (pos < L - 1) xp = *(const u32x4*)(sp + ldsb);
    float r[8];
    r[0] = silu_f(W.w0a[0] * bflo(xm.x) + W.w1a[0] * bflo(x0.x) + W.w2a[0] * bflo(xp.x) + W.ba[0]);
    r[1] = silu_f(W.w0a[1] * bfhi(xm.x) + W.w1a[1] * bfhi(x0.x) + W.w2a[1] * bfhi(xp.x) + W.ba[1]);
    r[2] = silu_f(W.w0a[2] * bflo(xm.y) + W.w1a[2] * bflo(x0.y) + W.w2a[2] * bflo(xp.y) + W.ba[2]);
    r[3] = silu_f(W.w0a[3] * bfhi(xm.y) + W.w1a[3] * bfhi(x0.y) + W.w2a[3] * bfhi(xp.y) + W.ba[3]);
    r[4] = silu_f(W.w0b[0] * bflo(xm.z) + W.w1b[0] * bflo(x0.z) + W.w2b[0] * bflo(xp.z) + W.bb[0]);
    r[5] = silu_f(W.w0b[1] * bfhi(xm.z) + W.w1b[1] * bfhi(x0.z) + W.w2b[1] * bfhi(xp.z) + W.bb[1]);
    r[6] = silu_f(W.w0b[2] * bflo(xm.w) + W.w1b[2] * bflo(x0.w) + W.w2b[2] * bflo(xp.w) + W.bb[2]);
    r[7] = silu_f(W.w0b[3] * bfhi(xm.w) + W.w1b[3] * bfhi(x0.w) + W.w2b[3] * bfhi(xp.w) + W.bb[3]);
    u32x4 w; w.x = cvt_pk(r[0], r[1]); w.y = cvt_pk(r[2], r[3]); w.z = cvt_pk(r[4], r[5]); w.w = cvt_pk(r[6], r[7]); return w;
}
__device__ __forceinline__ void conv_c_tile(const P& p, LAS unsigned char* lds, int ldsoff, int li, int pass, int gl, int tok0, int tid, unsigned char* gcopy) {
    const float* cw = p.ssd_conv_w + (size_t)li * 3 * 4096; const float* cb = p.ssd_conv_b + (size_t)li * 4096;
    const int c8 = (tid & 15) * 8; const ConvW W = conv_w(cw, cb, 3072 + 256 * pass + gl * 128 + c8);
#pragma unroll
    for (int k = 0; k < 4; ++k) { const int l = (tid >> 4) + 32 * k;
        const u32x4 v = conv8(p.ws + O_RAWC, 512, tok0 + l, gl * 128 + c8, W);
        int ob = (l & 15) * 64 + (c8 & 31) * 2; ob ^= ((ob >> 9) & 1) << 5;
        *(LAS u32x4*)(lds + ldsoff + ((l >> 4) * 4 + (c8 >> 5)) * 1024 + ob) = v;
        if (gcopy) *(u32x4*)(gcopy + ((size_t)(tok0 + l) * 256 + gl * 128 + c8) * 2) = v; }
}
constexpr int L_C = 0, L_B = 32768, L_X = 65536, L_DT = 131072, L_CUM = 135168, L_SS = 139264, L_CF = 139264, L_WT = 143360;
__device__ __forceinline__ bf16x8 scale8(bf16x8 x, f32x4 wa, f32x4 wb) {
    union { bf16x8 v; u32x4 u; } r;
    r.u.x = cvt_pk(bf2f(x[0]) * wa[0], bf2f(x[1]) * wa[1]); r.u.y = cvt_pk(bf2f(x[2]) * wa[2], bf2f(x[3]) * wa[3]);
    r.u.z = cvt_pk(bf2f(x[4]) * wb[0], bf2f(x[5]) * wb[1]); r.u.w = cvt_pk(bf2f(x[6]) * wb[2], bf2f(x[7]) * wb[3]);
    return r.v;
}
__device__ void phase_s1(const P& p, unsigned char* sm, LAS unsigned char* lds, int layer, int pass) {
    const int li = layer >> 1, tid = otid(), wid = __builtin_amdgcn_readfirstlane(tid >> 6), lane = tid & 63, fr = lane & 15, fq = lane >> 4;
    const int fo = frag_off(fr, fq);
    float* sDT = (float*)(sm + L_DT); float* sCUM = (float*)(sm + L_CUM); float* sCF = (float*)(sm + L_CF); float* sWT = (float*)(sm + L_WT);
    unsigned char* ws = p.ws;
    const int G_ = (int)gridDim.x, wdx = (G_ & 7) == 0 ? ((int)blockIdx.x & 7) * (G_ >> 3) + ((int)blockIdx.x >> 3) : (int)blockIdx.x;
    const int per = (1280 + G_ - 1) / G_, hi_lo = wdx * per, hi_hi = hi_lo + per < 1280 ? hi_lo + per : 1280;
    int cur_item = -1;
    for (int hi = hi_lo; hi < hi_hi; ++hi) {
        const int item = hi >> 2, r = hi & 3;
        const int chunk = item >> 1, gl = item & 1, tok0 = chunk * 128, g = pass * 2 + gl;
        if (item != cur_item) {
            cur_item = item;
            __syncthreads();
            conv_c_tile(p, lds, L_C, li, pass, gl, tok0, tid, ws + O_CS);
            { const float* cw = p.ssd_conv_w + (size_t)li * 3 * 4096; const float* cb = p.ssd_conv_b + (size_t)li * 4096;
              { const int c8 = (tid & 15) * 8; const ConvW W = conv_w(cw, cb, 2048 + 256 * pass + gl * 128 + c8);
#pragma unroll
                for (int k = 0; k < 4; ++k) { const int l = (tid >> 4) + 32 * k;
                    *(LAS u32x4*)(lds + L_B + off_b(l, c8 >> 3)) = conv8(ws + O_RAWB, 512, tok0 + l, gl * 128 + c8, W); } }
              { const int r_first = hi & 3, n_here = hi_hi - hi, r_last = r_first + n_here - 1 < 3 ? r_first + n_here - 1 : 3;
                for (int rr = r_first; rr <= r_last; ++rr) { const int c8 = rr * 64 + (tid & 7) * 8; const ConvW W = conv_w(cw, cb, 512 * pass + gl * 256 + c8);
#pragma unroll
                    for (int k = 0; k < 2; ++k) { const int l = (tid >> 3) + 64 * k;
                        *(LAS u32x4*)(lds + L_X + (c8 >> 7) * 32768 + off_b(l, (c8 & 127) >> 3)) = conv8(ws + O_RAWX, 1024, tok0 + l, gl * 256 + c8, W); } } } }
            { const int r4 = tid >> 7, pos = tid & 127, h = g * 4 + r4; const float* dr = (const float*)(ws + O_DTR) + (size_t)(tok0 + pos) * 64;
#pragma unroll
              for (int d = 0; d < 2; ++d) { const float raw = dr[d * 32 + h] + p.ssd_dt_bias[(li * 2 + d) * 32 + h];
                  const float dt = raw > 20.f ? raw : log1pf(__expf(raw)); const float a = -__expf(p.ssd_a_log[(li * 2 + d) * 32 + h]);
                  sDT[(r4 * 2 + d) * 128 + pos] = dt; sCUM[(r4 * 2 + d) * 128 + pos] = dt * a; } }
            __syncthreads();
            { float* cu = sCUM + wid * 128; const int d = wid & 1, r4 = wid >> 1, hl = gl * 4 + r4; const int e0 = d ? 127 - 2 * lane : 2 * lane, e1 = d ? e0 - 1 : e0 + 1;
              const float v0 = cu[e0], v1 = cu[e1], sv = v0 + v1; float inc = sv;
#pragma unroll
              for (int o = 1; o < 64; o <<= 1) { const float t = __shfl_up(inc, o); if (lane >= o) inc += t; }
              const float exc = inc - sv, c0 = exc + v0, c1 = exc + sv; cu[e0] = c0; cu[e1] = c1;
              float* CUMG = (float*)(ws + O_CUM);
              CUMG[((size_t)(tok0 + e0) * 2 + d) * 8 + hl] = c0; CUMG[((size_t)(tok0 + e1) * 2 + d) * 8 + hl] = c1;
              if (lane == 63) ((float*)(ws + O_DEC))[(chunk * 2 + d) * 8 + hl] = __expf(inc); }
            asm volatile("s_waitcnt vmcnt(0)" ::: "memory"); __syncthreads();
#pragma unroll
            for (int q = 0; q < 2; ++q) { const int idx = tid + q * 512, w8 = idx >> 7, pos = idx & 127, d = w8 & 1; const float* cu = sCUM + w8 * 128;
                const float cv = cu[pos], dtv = sDT[idx], ref = d ? cu[pos | 7] : cu[pos & ~7], tot = d ? cu[0] : cu[127];
                sCF[idx] = dtv * __expf(fminf(ref - cv, 80.f)); sWT[idx] = dtv * __expf(tot - cv); }
            { f32x4 cb[8];
#pragma unroll
              for (int st = 0; st < 8; ++st) cb[st] = (f32x4){0.f, 0.f, 0.f, 0.f};
#pragma unroll
              for (int kb = 0; kb < 4; ++kb) { const bf16x8 cf = LDFRAG(lds, L_C + (wid * 4 + kb) * 1024 + fo);
#pragma unroll
                  for (int st = 0; st < 8; ++st) { const bf16x8 bfr = LDFRAG(lds, L_B + off_b(16 * st + fr, 4 * kb + fq)); cb[st] = MFMA(bfr, cf, cb[st]); } }
              __syncthreads();
#pragma unroll
              for (int st = 0; st < 8; ++st) { int ob = fr * 64 + ((st & 1) * 16 + 4 * fq) * 2; ob ^= ((ob >> 9) & 1) << 5;
                  u32x2 w; w.x = cvt_pk(cb[st][0], cb[st][1]); w.y = cvt_pk(cb[st][2], cb[st][3]);
                  *(LAS u32x2*)(lds + L_C + (wid * 4 + (st >> 1)) * 1024 + ob) = w; } }
            __syncthreads();
        }
        { const int lt = wid, h = g * 4 + r; const float Dh = p.ssd_d[li * 32 + h];
          const float* cF = sCUM + (r * 2) * 128; const float* cR = cF + 128; const float* kF = sCF + (r * 2) * 128; const float* kR = kF + 128;
          f32x4 acc[4];
#pragma unroll
          for (int pt = 0; pt < 4; ++pt) acc[pt] = (f32x4){0.f, 0.f, 0.f, 0.f};
          const int l = lt * 16 + fr; const float cfl = cF[l], crl = cR[l];
#pragma unroll 1
          for (int kb = 0; kb < 4; ++kb) { const bf16x8 cbf = LDFRAG(lds, L_C + (lt * 4 + kb) * 1024 + fo); const int s0 = kb * 32 + fq * 8;
              bf16x8 xa[4];
#pragma unroll
              for (int pt = 0; pt < 4; ++pt) xa[pt] = trfrag(lds + L_X + (r >> 1) * 32768, lane, (r & 1) * 4 + pt, kb);
              const int rel = lt - 2 * kb;
              float mv[8];
              if (rel >= 2) { const float rf = __expf(cfl - cF[s0]); const f32x4 ka = *(const f32x4*)(kF + s0), kb4 = *(const f32x4*)(kF + s0 + 4);
#pragma unroll
                  for (int j = 0; j < 4; ++j) { mv[j] = bf2f(cbf[j]) * (rf * ka[j]); mv[4 + j] = bf2f(cbf[4 + j]) * (rf * kb4[j]); }
              } else if (rel < 0) { const float rr = __expf(crl - cR[s0 + 7]); const f32x4 ka = *(const f32x4*)(kR + s0), kb4 = *(const f32x4*)(kR + s0 + 4);
#pragma unroll
                  for (int j = 0; j < 4; ++j) { mv[j] = bf2f(cbf[j]) * (rr * ka[j]); mv[4 + j] = bf2f(cbf[4 + j]) * (rr * kb4[j]); }
              } else { const float rf = __expf(fminf(cfl - cF[s0], 0.f)), rr = __expf(fminf(crl - cR[s0 + 7], 0.f)), dsum = sDT[(r * 2) * 128 + l] + sDT[(r * 2 + 1) * 128 + l];
                  const f32x4 fa = *(const f32x4*)(kF + s0), fb = *(const f32x4*)(kF + s0 + 4), ra = *(const f32x4*)(kR + s0), rb = *(const f32x4*)(kR + s0 + 4);
#pragma unroll
                  for (int j = 0; j < 8; ++j) { const int sidx = s0 + j; const float kf = j < 4 ? fa[j & 3] : fb[j & 3], kr = j < 4 ? ra[j & 3] : rb[j & 3];
                      const float wgt = sidx < l ? rf * kf : (sidx > l ? rr * kr : dsum);
                      mv[j] = bf2f(cbf[j]) * wgt + (sidx == l ? Dh : 0.f); } }
              union { bf16x8 v; u32x4 u; } mf; mf.u.x = cvt_pk(mv[0], mv[1]); mf.u.y = cvt_pk(mv[2], mv[3]); mf.u.z = cvt_pk(mv[4], mv[5]); mf.u.w = cvt_pk(mv[6], mv[7]);
#pragma unroll
              for (int pt = 0; pt < 4; ++pt) acc[pt] = MFMA(xa[pt], mf.v, acc[pt]); }
          unsigned char* yp = ws + O_YD + ((size_t)(tok0 + l) * 512 + gl * 256 + r * 64 + 4 * fq) * 2;
#pragma unroll
          for (int pt = 0; pt < 4; ++pt) { u32x2 w; w.x = cvt_pk(acc[pt][0], acc[pt][1]); w.y = cvt_pk(acc[pt][2], acc[pt][3]); *(u32x2*)(yp + pt * 32) = w; } }
        { const int d = wid & 1, pq = wid >> 1, hl = gl * 4 + r; const float* wt = sWT + (r * 2 + d) * 128;
          f32x4 acc[8];
#pragma unroll
          for (int a = 0; a < 8; ++a) acc[a] = (f32x4){0.f, 0.f, 0.f, 0.f};
#pragma unroll
          for (int kb = 0; kb < 4; ++kb) { const int l0 = kb * 32 + fq * 8; const f32x4 wa = *(const f32x4*)(wt + l0), wb = *(const f32x4*)(wt + l0 + 4);
              const bf16x8 xb = scale8(trfrag(lds + L_X + (r >> 1) * 32768, lane, (r & 1) * 4 + pq, kb), wa, wb);
#pragma unroll
              for (int n2 = 0; n2 < 8; ++n2) { const bf16x8 af = trfrag(lds + L_B, lane, n2, kb); acc[n2] = MFMA(af, xb, acc[n2]); } }
          unsigned char* sp = ws + O_ST + ((size_t)((chunk * 2 + d) * 8 + hl) * 64) * 256;
#pragma unroll
          for (int n2 = 0; n2 < 8; ++n2) { u32x2 w; w.x = cvt_pk(acc[n2][0], acc[n2][1]); w.y = cvt_pk(acc[n2][2], acc[n2][3]);
              *(u32x2*)(sp + ((size_t)(pq * 16 + fr) * 128 + n2 * 16 + 4 * fq) * 2) = w; } }
    }
}
__device__ void phase_s2(const P& p, int layer, int pass) {
    const int li = layer >> 1; unsigned char* ws = p.ws;
    const long gt = (long)blockIdx.x * 512 + otid(), gn = (long)gridDim.x * 512;
    const float* DEC = (const float*)(ws + O_DEC);
    for (long it = gt; it < 393216; it += gn) {
        const int n8 = (int)(it & 15), pp = (int)(it >> 4) & 63, hl = (int)(it >> 10) & 7, d = (int)(it >> 13) & 1, seq = (int)(it >> 14);
        const int nc = seq < 16 ? 2 : 16, c0 = seq < 16 ? seq * 2 : 32 + (seq - 16) * 16, h = pass * 8 + hl;
        f32x4 ha = (f32x4){0.f, 0.f, 0.f, 0.f}, hb = ha;
        if (seq >= 16) { const float* s0 = p.state + ((((size_t)(seq - 16) * 2 + li) * 2 + d) * 32 + h) * 8192 + pp * 128 + n8 * 8; ha = *(const f32x4*)s0; hb = *(const f32x4*)(s0 + 4); }
        const int nb = nc < 4 ? nc : 4;
        for (int k0 = 0; k0 < nc; k0 += nb) {
            u32x4 sv[4]; float dc[4]; unsigned char* pt[4];
#pragma unroll
            for (int j = 0; j < 4; ++j) if (j < nb) { const int k = k0 + j, c = d ? c0 + nc - 1 - k : c0 + k; dc[j] = DEC[(c * 2 + d) * 8 + hl];
                pt[j] = ws + O_ST + (((size_t)((c * 2 + d) * 8 + hl) * 64 + pp) * 128 + n8 * 8) * 2; sv[j] = *(const u32x4*)pt[j]; }
#pragma unroll
            for (int j = 0; j < 4; ++j) if (j < nb) { const float dec = dc[j];
                u32x4 w; w.x = cvt_pk(ha[0], ha[1]); w.y = cvt_pk(ha[2], ha[3]); w.z = cvt_pk(hb[0], hb[1]); w.w = cvt_pk(hb[2], hb[3]);
                *(u32x4*)pt[j] = w;
                ha[0] = ha[0] * dec + bflo(sv[j].x); ha[1] = ha[1] * dec + bfhi(sv[j].x); ha[2] = ha[2] * dec + bflo(sv[j].y); ha[3] = ha[3] * dec + bfhi(sv[j].y);
                hb[0] = hb[0] * dec + bflo(sv[j].z); hb[1] = hb[1] * dec + bfhi(sv[j].z); hb[2] = hb[2] * dec + bflo(sv[j].w); hb[3] = hb[3] * dec + bfhi(sv[j].w); } }
        if (seq < 16) { float* o = p.out + OUT_STATE_OFF + ((((size_t)seq * 2 + li) * 2 + d) * 32 + h) * 8192 + pp * 128 + n8 * 8; *(f32x4*)o = ha; *(f32x4*)(o + 4) = hb; }
    }
}
__device__ void phase_s3(const P& p, unsigned char* sm, LAS unsigned char* lds, int layer, int pass) {
    const int li = layer >> 1, tid = otid(), wid = __builtin_amdgcn_readfirstlane(tid >> 6), lane = tid & 63, fr = lane & 15, fq = lane >> 4;
    const int fo = frag_off(fr, fq);
    float* sSC = (float*)(sm + L_DT); float* sSS = (float*)(sm + L_SS);
    unsigned char* ws = p.ws;
    const int G_ = (int)gridDim.x, wdx = (G_ & 7) == 0 ? ((int)blockIdx.x & 7) * (G_ >> 3) + ((int)blockIdx.x >> 3) : (int)blockIdx.x;
    const int per = (1280 + G_ - 1) / G_, q_lo = wdx * per, q_hi = q_lo + per < 1280 ? q_lo + per : 1280;
    const int r = wid >> 1, ph = wid & 1;
    int cur_item = -1;
    bf16x8 hh[2][4][2];
#pragma unroll
    for (int d = 0; d < 2; ++d)
#pragma unroll
        for (int kb = 0; kb < 4; ++kb) { hh[d][kb][0] = (bf16x8){0, 0, 0, 0, 0, 0, 0, 0}; hh[d][kb][1] = hh[d][kb][0]; }
    for (int qi = q_lo; qi < q_hi; ++qi) {
        const int item = qi >> 2, lq = qi & 3;
        const int chunk = item >> 1, gl = item & 1, tok0 = chunk * 128, g = pass * 2 + gl;
        if (item != cur_item) {
            cur_item = item;
            __syncthreads();
            stage_tile(lds, L_C, ws + O_CS + ((size_t)tok0 * 256 + gl * 128) * 2, 512, 8, 4, wid, lane);
            { const unsigned char* hin0 = ws + O_ST + ((size_t)((chunk * 2) * 8 + gl * 4 + r) * 64 + ph * 32) * 256 + ((size_t)fr * 128 + fq * 8) * 2;
#pragma unroll
              for (int d = 0; d < 2; ++d)
#pragma unroll
                  for (int kb = 0; kb < 4; ++kb) { hh[d][kb][0] = *(const bf16x8*)(hin0 + (size_t)d * 131072 + kb * 64); hh[d][kb][1] = *(const bf16x8*)(hin0 + (size_t)d * 131072 + kb * 64 + 16 * 256); } }
            { const float* CUMG = (const float*)(ws + O_CUM);
#pragma unroll
              for (int q = 0; q < 2; ++q) { const int idx = tid + q * 512, l = idx & 127, w8 = idx >> 7, r4 = w8 >> 1, d = w8 & 1;
                  sSC[w8 * 128 + l] = __expf(CUMG[((size_t)(tok0 + l) * 2 + d) * 8 + gl * 4 + r4]); } }
            asm volatile("s_waitcnt vmcnt(0)" ::: "memory"); __syncthreads();
        }
        f32x4 acc[2][2], aR[2][2], ggv[2];
        { const float* ng = p.ssd_norm_g + (size_t)li * 2048 + g * 256 + r * 64 + ph * 32 + 4 * fq; ggv[0] = *(const f32x4*)ng; ggv[1] = *(const f32x4*)(ng + 16); }
        u32x2 ydv[2][2], zzv[2][2];
#pragma unroll
        for (int i = 0; i < 2; ++i)
#pragma unroll
            for (int pt = 0; pt < 2; ++pt) { const size_t o = ((size_t)(tok0 + (lq * 2 + i) * 16 + fr) * 512 + gl * 256 + r * 64 + ph * 32 + pt * 16 + 4 * fq) * 2;
                ydv[i][pt] = *(const u32x2*)(ws + O_YD + o); zzv[i][pt] = *(const u32x2*)(ws + O_Z + o); }
#pragma unroll
        for (int i = 0; i < 2; ++i) { acc[i][0] = (f32x4){0.f, 0.f, 0.f, 0.f}; acc[i][1] = acc[i][0]; aR[i][0] = acc[i][0]; aR[i][1] = acc[i][0]; }
#pragma unroll
        for (int kb = 0; kb < 4; ++kb)
#pragma unroll
            for (int i = 0; i < 2; ++i) { const bf16x8 cf = LDFRAG(lds, L_C + ((lq * 2 + i) * 4 + kb) * 1024 + fo);
                acc[i][0] = MFMA(hh[0][kb][0], cf, acc[i][0]); acc[i][1] = MFMA(hh[0][kb][1], cf, acc[i][1]);
                aR[i][0] = MFMA(hh[1][kb][0], cf, aR[i][0]); aR[i][1] = MFMA(hh[1][kb][1], cf, aR[i][1]); }
#pragma unroll
        for (int i = 0; i < 2; ++i) { const int l = (lq * 2 + i) * 16 + fr; float ss = 0.f;
            const float sf = sSC[(r * 2) * 128 + l], sr = sSC[(r * 2 + 1) * 128 + l];
#pragma unroll
            for (int pt = 0; pt < 2; ++pt) { const u32x2 yd = ydv[i][pt], zz = zzv[i][pt];
                f32x4 v = acc[i][pt] * sf + aR[i][pt] * sr;
                v[0] = (v[0] + bflo(yd.x)) * silu_f(bflo(zz.x)); v[1] = (v[1] + bfhi(yd.x)) * silu_f(bfhi(zz.x));
                v[2] = (v[2] + bflo(yd.y)) * silu_f(bflo(zz.y)); v[3] = (v[3] + bfhi(yd.y)) * silu_f(bfhi(zz.y));
                acc[i][pt] = v; ss += v[0] * v[0] + v[1] * v[1] + v[2] * v[2] + v[3] * v[3]; }
            ss += __shfl_xor(ss, 16); ss += __shfl_xor(ss, 32);
            if (fq == 0) sSS[(qi & 1) * 256 + wid * 32 + i * 16 + fr] = ss; }
        __syncthreads();
#pragma unroll
        for (int i = 0; i < 2; ++i) { const int l = (lq * 2 + i) * 16 + fr; float tot = 0.f;
#pragma unroll
            for (int w = 0; w < 8; ++w) tot += sSS[(qi & 1) * 256 + w * 32 + i * 16 + fr];
            const float rstd = rsqrtf(tot * (1.0f / 256.f) + 1e-6f);
#pragma unroll
            for (int pt = 0; pt < 2; ++pt) { const f32x4 gg = ggv[pt]; const f32x4 v = acc[i][pt];
                u32x2 w; w.x = cvt_pk(v[0] * rstd * gg[0], v[1] * rstd * gg[1]); w.y = cvt_pk(v[2] * rstd * gg[2], v[3] * rstd * gg[3]);
                *(u32x2*)(ws + O_YN + ((size_t)(tok0 + l) * 2048 + g * 256 + r * 64 + ph * 32 + pt * 16 + 4 * fq) * 2) = w; } }
    }
}
__device__ void phase_final(const P& p) {
    const int tid = otid(), lane = tid & 63, gw = blockIdx.x * 8 + (tid >> 6), nw = gridDim.x * 8;
    const int rpw = (TOK + nw - 1) / nw, r_lo = gw * rpw, r_hi = r_lo + rpw < TOK ? r_lo + rpw : TOK;
    f32x4 g[4];
#pragma unroll
    for (int i = 0; i < 4; ++i) g[i] = *(const f32x4*)(p.final_norm_g + i * 256 + lane * 4);
    for (int t0 = r_lo; t0 < r_hi; t0 += 4) {
        f32x4 v[4][4]; float ss[4];
#pragma unroll
        for (int j = 0; j < 4; ++j) { const int t = t0 + j < r_hi ? t0 + j : r_hi - 1; const float* xr = p.out + (size_t)t * 1024;
#pragma unroll
            for (int i = 0; i < 4; ++i) v[j][i] = *(const f32x4*)(xr + i * 256 + lane * 4); }
#pragma unroll
        for (int j = 0; j < 4; ++j) { float a = 0.f;
#pragma unroll
            for (int i = 0; i < 4; ++i) a += v[j][i][0] * v[j][i][0] + v[j][i][1] * v[j][i][1] + v[j][i][2] * v[j][i][2] + v[j][i][3] * v[j][i][3];
            ss[j] = a; }
#pragma unroll
        for (int o = 32; o >= 1; o >>= 1) {
#pragma unroll
            for (int j = 0; j < 4; ++j) ss[j] += __shfl_xor(ss[j], o); }
#pragma unroll
        for (int j = 0; j < 4; ++j) if (t0 + j < r_hi) { const float rstd = rsqrtf(ss[j] * (1.0f / 1024.f) + 1e-6f); float* xr = p.out + (size_t)(t0 + j) * 1024;
#pragma unroll
            for (int i = 0; i < 4; ++i) *(f32x4*)(xr + i * 256 + lane * 4) = v[j][i] * rstd * g[i]; }
    }
}

__global__ void __launch_bounds__(512, 2) mega(P p) {
    extern __shared__ __attribute__((aligned(16))) unsigned char smem[];
    LAS unsigned char* lds = (LAS unsigned char*)smem;
    cg::grid_group grid = cg::this_grid();
    XcdBarrier xb; xb.bar = (unsigned*)(p.ws + WS_BAR); xb.x = xb_xcc_id(); xb.st = (volatile LAS unsigned*)(lds + 147456);
    if (threadIdx.x == 0) { xb.st[0] = 0u; xb.st[1] = 0u; (void)xb_add(&xb.bar[XB_XCNT(xb.x)], 1u); }
    __syncthreads();
    const int G = gridDim.x, c = blockIdx.x;
    if (p.ph0 < 0) grid.sync();
#ifndef REP_MASK
#define REP_MASK 0
#endif
    for (int ph = p.ph0; ph < p.ph1; ++ph) {
        int kind, layer = 0, pass = 0;
        if (ph < 2) kind = ph;
        else if (ph == 54) kind = 13;
        else { const int q = ph - 2, blk = q / 26; int r = q - blk * 26; layer = blk * 2;
            if (r < 8) { if (r < 6) { pass = r / 3; kind = 2 + (r - pass * 3); } else kind = r == 6 ? 5 : 6; }
            else { r -= 8; layer += 1; if (r == 0) kind = 7; else if (r == 17) kind = 6; else { pass = (r - 1) / 4; const int sub = r - 1 - pass * 4; kind = sub == 0 ? 8 : 9 + sub; } } }
        const int cls = (kind == 3 || kind == 8) ? 1 : kind == 5 ? 2 : kind == 4 ? 4 : kind == 9 ? 8 : kind == 10 ? 16 : kind == 12 ? 32 : (kind == 2 || kind == 7) ? 64 : kind < 2 ? 128 : 0;
        const int nrep = ((REP_MASK) & cls) ? 2 : 1;
        bool skip_bar = false;
        for (int rep = 0; rep < nrep; ++rep) {
            if (rep) grid_barrier(xb);
            switch (kind) {
            case 0: phase_prep0(p, smem); break;
            case 1: { UF_Prep1 uf{p.ws, G, c}; gemm_phase<true>(lds, 512, 2048, 4, 1 << 30, 0L, 0L, uf, EpiBf16{}); __syncthreads(); phase_normE(p, smem, 0, 0); } break;
            case 2: if ((layer == 0 && pass == 0) || pass == 1) skip_bar = true; else phase_normE(p, smem, layer, pass); break;
            case 3: { UF_G1E uf{&p, layer >> 1, pass, G, c}; gemm_phase<true>(lds, 2048, 2048, 16, 1 << 30, 0L, 0L, uf, EpiBf16{}); } break;
            case 4: phase_e3(p, layer, pass); if (pass == 0) phase_normE(p, smem, layer, 1); break;
            case 5: { UF_E4L uf{&p, G, c}; gemm_phase<true>(lds, 4096, 8192, 32, 16, 0L, 2048L, uf, EpiBf16{});
                      UF_E4C uc{&p, G, c}; gemm_phase<true>(lds, 1024, 1024, 8, 1 << 30, 0L, 0L, uc, EpiBf16{}); } break;
            case 6: { const bool even = (layer & 1) == 0; const int lda = even ? 2048 : 4096, tseg = even ? 16 : (1 << 30); const long segoff = even ? (long)(E_YB - E_YA) - 2048L : 0L;
                      UF_G2 uf{&p, layer, 0, G, c}; gemm_phase<false, false>(lds, lda, 4096, 32, tseg, segoff, 0L, uf, EpiResT<false>{});
                      UF_G2 uh{&p, layer, 1, G, c}; gemm_phase<false, true>(lds, lda, 4096, 32, tseg, segoff, 0L, uh, EpiResT<true>{});
                      if (layer < 3) {
                          const int nh = G > 128 ? 128 : 0, rank = c - nh, nblk = G - nh;
                          if (rank >= 0) { __syncthreads(); if (even) conv_odd(p, smem, layer + 1, rank, nblk); else conv_even(p, smem, layer + 1, rank, nblk); } } } break;
            case 7: phase_normO(p, smem, layer); break;
            case 8: { UF_G1O uf{p.ws, pass, pass == 0 ? 7 : 6, G, c}; gemm_phase<true>(lds, 2048, 2048, 16, 1 << 30, 0L, 0L, uf, EpiBf16{}); } break;
            case 9: phase_o3(p, smem, layer, pass); break;
            case 10: phase_s1(p, smem, lds, layer, pass); break;
            case 11: phase_s2(p, layer, pass); break;
            case 12: phase_s3(p, smem, lds, layer, pass); break;
            default: phase_final(p); break;
            }
        }
        if (!skip_bar && ph + 1 < p.ph1) { grid_barrier(xb); if ((REP_MASK) & 512) grid_barrier(xb); }
    }
}
constexpr int N_PHASES = 55;

extern "C" void kernel_launch(void* const* d_in, const int* in_sizes, int n_in, void* d_out, int out_size, void* d_ws, size_t ws_size, hipStream_t stream) {
    static int grid = 0;
    if (grid == 0) {
        if (ws_size < WS_NEED) { fprintf(stderr, "kernel_launch: workspace too small: %zu < %zu\n", ws_size, (size_t)WS_NEED); grid = -1; return; }
        int dev = 0, cus = 0, per_cu = 0;
        hipGetDevice(&dev); hipDeviceGetAttribute(&cus, hipDeviceAttributeMultiprocessorCount, dev);
        hipFuncSetAttribute((const void*)mega, hipFuncAttributeMaxDynamicSharedMemorySize, LDS_BYTES);
        hipOccupancyMaxActiveBlocksPerMultiprocessor(&per_cu, (const void*)mega, 512, LDS_BYTES);
        if (per_cu < 1) { fprintf(stderr, "kernel_launch: occupancy query says %d blocks per CU\n", per_cu); grid = -1; return; }
        grid = cus;
        if (grid > 256) grid = 256;
    }
    if (grid < 0) return;
    hipMemsetAsync((char*)d_ws + WS_BAR, 0, 16384, stream);
    P p{};
    const float** pp = (const float**)&p;
    for (int i = 0; i < 20; ++i) pp[i] = (const float*)d_in[i];
    p.out = (float*)d_out; p.ws = (unsigned char*)d_ws; p.ph0 = 0; p.ph1 = N_PHASES;
#ifdef DBG_PH1
    p.ph1 = DBG_PH1;
#endif
    void* args[] = {&p};
    hipError_t e = hipLaunchCooperativeKernel((const void*)mega, dim3(grid), dim3(512), args, LDS_BYTES, stream);
    if (e != hipSuccess) fprintf(stderr, "cooperative launch failed: %s (grid %d)\n", hipGetErrorString(e), grid);
}
```

```cpp
#include <hip/hip_runtime.h>
#include <hip/hip_cooperative_groups.h>
#include <cstdio>
#include <cstring>
namespace cg = cooperative_groups;

#define LAS __attribute__((address_space(3)))
typedef unsigned short bf16_t;
typedef short bf16x8 __attribute__((ext_vector_type(8)));
typedef float f32x4 __attribute__((ext_vector_type(4)));
typedef unsigned u32x4 __attribute__((ext_vector_type(4)));
typedef unsigned u32x2 __attribute__((ext_vector_type(2)));

constexpr int TOK = 20480, TOKC = 4096;
constexpr size_t SLOT = 2097152;
constexpr size_t OUT_STATE_OFF = (size_t)TOK * 1024;

constexpr size_t WS_BAR = 0;
constexpr size_t WS_MOD = 16384;
constexpr size_t WS_TC = 524288;
constexpr size_t WS_ALC = 786432;
constexpr size_t WS_WF = 1048576;
constexpr size_t WS_BIG = 9437184;
constexpr size_t WS_WUBF = WS_BIG;
constexpr size_t E_VTC = WS_BIG;
constexpr size_t E_VTL = E_VTC + 16777216;
constexpr size_t E_ZA = WS_BIG + 83886080;
constexpr size_t E_YB = E_ZA + 41943040;
constexpr int E_T0 = 38, E_T1 = 42;
constexpr size_t E_PS = (size_t)E_T1 * 256 * 2048;
constexpr size_t E_HM = E_YB + 41943040;
constexpr size_t E_PL = E_HM + E_PS;
constexpr size_t E_YA = E_PL;
constexpr size_t E_END = E_PL + 4 * E_PS;
constexpr size_t O_WIN = WS_BIG;
constexpr size_t O_WOUT = O_WIN + 13107200;
constexpr size_t O_HM = O_WOUT + 4194304;
constexpr size_t O_YN = O_HM + 41943040;
constexpr size_t O_DTR = O_YN + 83886080;
constexpr size_t O_Z = O_DTR + 5242880;
constexpr size_t O_RAWX = O_Z + 20971520;
constexpr size_t O_RAWB = O_RAWX + 20971520;
constexpr size_t O_RAWC = O_RAWB + 10485760;
constexpr size_t O_XT = O_RAWC + 10485760;
constexpr size_t O_BS = O_XT + 20971520;
constexpr size_t O_BT = O_BS + 10485760;
constexpr size_t O_CS = O_BT + 10485760;
constexpr size_t O_ST = O_XT;
constexpr size_t O_YD = O_CS + 10485760;
constexpr size_t O_CUM = O_YD + 20971520;
constexpr size_t O_DEC = O_CUM + 1310720;
constexpr size_t O_END = O_DEC + 16384;
constexpr size_t WS_NEED = (O_END > E_END ? O_END : E_END);

constexpr int LDS_BYTES = 147520;

struct P {
    const float *x_prompt, *x_sample, *state, *c, *c_ctx, *w_mod, *b_mod, *norm_g, *fc_w_in, *fc_conv_w, *fc_w_out, *ssd_w_in, *ssd_conv_w,
        *ssd_conv_b, *ssd_dt_bias, *ssd_a_log, *ssd_d, *ssd_norm_g, *ssd_w_out, *final_norm_g;
    float* out; unsigned char* ws; int ph0, ph1;
};

typedef __bf16 bf16v2 __attribute__((ext_vector_type(2)));
typedef float f32x2 __attribute__((ext_vector_type(2)));
__device__ __forceinline__ unsigned cvt_pk(float lo, float hi) { const f32x2 v = {lo, hi}; const bf16v2 b = __builtin_convertvector(v, bf16v2); return __builtin_bit_cast(unsigned, b); }
__device__ __forceinline__ float bflo(unsigned u) { return __uint_as_float(u << 16); }
__device__ __forceinline__ float bfhi(unsigned u) { return __uint_as_float(u & 0xFFFF0000u); }
__device__ __forceinline__ float bf2f(short s) { return __uint_as_float(((unsigned)(unsigned short)s) << 16); }
__device__ __forceinline__ float silu_f(float x) { return x * __builtin_amdgcn_rcpf(1.0f + __expf(-x)); }
__device__ __forceinline__ unsigned char* slot_ptr(const P& p, int b, int i) { return (unsigned char*)(p.out + OUT_STATE_OFF) + ((size_t)b * 2 + i) * SLOT; }
__device__ __forceinline__ int cond_of_tile(int pm) { return pm < 16 ? 0 : 1 + ((pm - 16) >> 3); }
__device__ __forceinline__ int cond_of_tok(int tok) { return tok < TOKC ? 0 : 1 + ((tok - TOKC) >> 11); }

__device__ __forceinline__ int otid() { int t; asm volatile("v_mov_b32 %0, %1" : "=v"(t) : "v"((int)threadIdx.x)); return t; }
__device__ __forceinline__ int frag_off(int fr, int fq) { int ob = fr * 64 + fq * 16; return ob ^ (((ob >> 9) & 1) << 5); }
__device__ __forceinline__ void stage_tile(LAS unsigned char* lds, int ldsoff, const unsigned char* g, long ldb, int R16, int K32, int wid, int lane) {
    const int b = lane * 16, swz = b ^ (((b >> 9) & 1) << 5), rr = swz >> 6, cc = (swz & 63) >> 1;
    for (int st = wid; st < R16 * K32; st += 8) {
        const int rb = st / K32, kb = st - rb * K32;
        const unsigned char* src = g + (long)(rb * 16 + rr) * ldb + (kb * 32 + cc) * 2;
        __builtin_amdgcn_global_load_lds((const unsigned*)src, (LAS unsigned*)(lds + ldsoff + st * 1024), 16, 0, 0);
    }
}
#define LDFRAG(lds, off) (*(const LAS bf16x8*)((lds) + (off)))
typedef short s16x4 __attribute__((ext_vector_type(4)));
__device__ __forceinline__ unsigned off_b(unsigned row, unsigned ch) { return 256u * row + 16u * (ch ^ (((row & 3u) << 2) | ((row >> 2) & 3u))); }
__device__ __forceinline__ void stage_img(LAS unsigned char* lds, int ldsoff, const unsigned char* g, long ld, int wid, int lane) {
    const unsigned rr = lane >> 4, pch = lane & 15;
    for (int i = wid; i < 32; i += 8) { const unsigned row = 4 * i + rr, ch = pch ^ (((row & 3u) << 2) | ((row >> 2) & 3u));
        __builtin_amdgcn_global_load_lds((const unsigned*)(g + (long)row * ld + ch * 16), (LAS unsigned*)(lds + ldsoff + i * 1024), 16, 0, 0); }
}
__device__ __forceinline__ bf16x8 trfrag(LAS unsigned char* img, int lane, int c, int ks) {
    const unsigned g = lane >> 4, q = (lane & 15) >> 2, pp = lane & 3;
    const unsigned a0 = off_b(32 * ks + 8 * g + q, 2 * c + (pp >> 1)) + 8 * (pp & 1), a1 = off_b(32 * ks + 8 * g + 4 + q, 2 * c + (pp >> 1)) + 8 * (pp & 1);
    const s16x4 x = __builtin_amdgcn_ds_read_tr16_b64_v4i16((LAS s16x4*)(img + a0)), y = __builtin_amdgcn_ds_read_tr16_b64_v4i16((LAS s16x4*)(img + a1));
    return (bf16x8){x[0], x[1], x[2], x[3], y[0], y[1], y[2], y[3]};
}
#define MFMA(a, b, c) __builtin_amdgcn_mfma_f32_16x16x32_bf16((a), (b), (c), 0, 0, 0)

#define XB_TMO      128
#define XB_XCNT(j)  (256  + 64 * (j))
#define XB_XSUB(j)  (1280 + 64 * (j))
#define XB_XGEN(j)  (2304 + 64 * (j))
#define XB_TOP      3328
#define XB_TOPGEN   3392
#define XB_SPIN_CAP (1u << 22)
__device__ __forceinline__ unsigned xb_ld(unsigned* p)              { return __hip_atomic_load(p, __ATOMIC_RELAXED, __HIP_MEMORY_SCOPE_AGENT); }
__device__ __forceinline__ unsigned xb_add(unsigned* p, unsigned v) { return __hip_atomic_fetch_add(p, v, __ATOMIC_RELAXED, __HIP_MEMORY_SCOPE_AGENT); }
__device__ __forceinline__ unsigned xb_xcc_id() { return (unsigned)__builtin_amdgcn_s_getreg((3 << 11) | 20) & 0xFu; }
#define XB_SPIN(cond, bar) do { unsigned _sp = 0; while (cond) { __builtin_amdgcn_s_sleep(1); \
    if ((++_sp & 255u) == 0u) { if (xb_ld(&(bar)[XB_TMO])) break; if (_sp > XB_SPIN_CAP) { atomicAdd(&(bar)[XB_TMO], 1u); break; } } } } while (0)
struct XcdBarrier { unsigned* bar; unsigned x; volatile LAS unsigned* st; };
__device__ __forceinline__ void xcd_barrier_complete(unsigned* bar, unsigned x, unsigned& nloc, unsigned& nx) {
    const unsigned G = gridDim.x;
    unsigned sum, cnt, mine, sp = 0u;
    for (;;) {
        sum = 0u; cnt = 0u; mine = 0u;
#pragma unroll
        for (unsigned j = 0; j < 16; ++j) { const unsigned c = xb_ld(&bar[XB_XCNT(j)]); sum += c; cnt += (c > 0u) ? 1u : 0u; mine = (j == x) ? c : mine; }
        if (sum == G) break;
        __builtin_amdgcn_s_sleep(1);
        if ((++sp & 255u) == 0u) { if (xb_ld(&bar[XB_TMO])) break; if (sp > XB_SPIN_CAP) { atomicAdd(&bar[XB_TMO], 1u); break; } }
    }
    nloc = mine > 0u ? mine : 1u; nx = cnt > 0u ? cnt : 1u;
}
__device__ __forceinline__ void grid_barrier(const XcdBarrier& b) {
    asm volatile("s_waitcnt vmcnt(0)" ::: "memory");
    __syncthreads();
    if (threadIdx.x == 0) {
        unsigned* bar = b.bar;
        __builtin_amdgcn_s_waitcnt(0);
        unsigned nloc = b.st[0], nx = b.st[1];
        if (nloc == 0u) { xcd_barrier_complete(bar, b.x, nloc, nx); b.st[0] = nloc; b.st[1] = nx; }
        const unsigned old = xb_add(&bar[XB_XSUB(b.x)], 1u);
        const unsigned gen = old / nloc;
        if (old + 1u == (gen + 1u) * nloc) {
            __builtin_amdgcn_fence(__ATOMIC_RELEASE, "agent");
            asm volatile("s_waitcnt vmcnt(0)" ::: "memory");
            const unsigned og = xb_add(&bar[XB_TOP], 1u);
            const unsigned tg = og / nx;
            if (og + 1u == (tg + 1u) * nx) xb_add(&bar[XB_TOPGEN], 1u);
            else XB_SPIN(xb_ld(&bar[XB_TOPGEN]) == tg, bar);
            __builtin_amdgcn_fence(__ATOMIC_ACQUIRE, "agent");
            xb_add(&bar[XB_XGEN(b.x)], 1u);
            asm volatile("s_waitcnt vmcnt(0)" ::: "memory");
        } else {
            XB_SPIN(xb_ld(&bar[XB_XGEN(b.x)]) == gen, bar);
            __builtin_amdgcn_fence(__ATOMIC_ACQUIRE, "agent");
            asm volatile("s_waitcnt vmcnt(0)" ::: "memory");
        }
    }
    __syncthreads();
}

struct Unit { const unsigned char* A; const unsigned char* B; unsigned char* O; const unsigned char* X; const float* G; int ldo; int kind; float scale; };
constexpr int HTB = 128 * 64 * 2;
__device__ __forceinline__ int lds_byte(int r, int c) { const int st = (r >> 4) * 2 + (c >> 5), rr = r & 15, cc = c & 31, ob = rr * 64 + cc * 2; return st * 1024 + (ob ^ (((ob >> 9) & 1) << 5)); }
__device__ __forceinline__ void stage_rc(int b, int& R, int& C) { const int st = b / 1024, sb = b % 1024, swz = sb ^ (((sb >> 9) & 1) << 5); R = (st >> 1) * 16 + swz / 64; C = (st & 1) * 32 + (swz % 64) / 2; }
__device__ __forceinline__ int perm32(int rho) { const int n = rho >> 4, i = rho & 15; return 8 * (i >> 2) + 4 * n + (i & 3); }
__device__ __forceinline__ void tile_order(int L, int nM, int nN, int& pm, int& pn) {
    const int nwg = nM * nN; int wgid = L;
    { const int q = nwg / 8, r = nwg % 8, xcd = wgid % 8, off = wgid / 8; wgid = (xcd < r ? xcd * (q + 1) : r * (q + 1) + (xcd - r) * q) + off; }
    const int nig = 8 * nN, gid = wgid / nig, fm = gid * 8, gsz = (nM - fm) < 8 ? (nM - fm) : 8;
    pm = fm + ((wgid % nig) % gsz); pn = (wgid % nig) / gsz;
}

template <bool PERM, bool HALFM = false, class UF, class Epi>
__device__ __forceinline__ void gemm_phase(LAS unsigned char* lds, const int lda, const int ldb, const int nt, const int tseg, const long segoff, const long segoffB, const UF& uf, const Epi& E) {
    const int tid = otid(), wid = __builtin_amdgcn_readfirstlane(tid >> 6), lane = tid & 63, wr = wid >> 2, wc = wid & 3, fr = lane & 15, fq = lane >> 4;
    unsigned voffA[2], voffB[2];
#pragma unroll
    for (int i = 0; i < 2; ++i) { int R, C; stage_rc(tid * 16 + i * 8192, R, C); const int Rb = PERM ? ((R & ~31) + perm32(R & 31)) : R;
        voffA[i] = (unsigned)(R * lda + C * 2); voffB[i] = (unsigned)(Rb * ldb + C * 2); }
    const long kstep = 128;
    const long hstepA = 128L * lda, hstepB = 128L * ldb;
    const unsigned ldsw = (unsigned)wid * 1024u;
    const int aoff = lds_byte(wr * 64 + fr, fq * 8), boff = lds_byte(wc * 32 + fr, fq * 8);
#define PG8_SA(b, h) (((b) * 2 + (h)) * HTB)
#define PG8_SB(b, h) ((4 + (b) * 2 + (h)) * HTB)
#define PG8_STAGE(bufoff, gbase, voff) do { _Pragma("unroll") for (int _i = 0; _i < 2; ++_i) \
        __builtin_amdgcn_global_load_lds((const unsigned*)((const unsigned char*)(gbase) + (voff)[_i]), (LAS unsigned*)(lds + (bufoff) + ldsw + _i * 8192), 16, 0, 0); } while (0)
#define PG8_LDA(dst, b, h) do { if (HALFM && (h) == 1) break; _Pragma("unroll") for (int m = 0; m < 4; ++m) _Pragma("unroll") for (int k = 0; k < 2; ++k) dst[m][k] = *(const LAS bf16x8*)(lds + PG8_SA(b, h) + aoff + m * 2048 + k * 1024); } while (0)
#define PG8_LDB(dst, b, h) do { _Pragma("unroll") for (int n = 0; n < 2; ++n) _Pragma("unroll") for (int k = 0; k < 2; ++k) dst[n][k] = *(const LAS bf16x8*)(lds + PG8_SB(b, h) + boff + n * 2048 + k * 1024); } while (0)
#define PG8_MMA(ai, bj, At, Bt) do { if (HALFM && (ai) == 1) break; __builtin_amdgcn_s_setprio(1); _Pragma("unroll") for (int m = 0; m < 4; ++m) _Pragma("unroll") for (int n = 0; n < 2; ++n) _Pragma("unroll") for (int k = 0; k < 2; ++k) \
        acc[ai][bj][m][n] = __builtin_amdgcn_mfma_f32_16x16x32_bf16(Bt[n][k], At[m][k], acc[ai][bj][m][n], 0, 0, 0); __builtin_amdgcn_s_setprio(0); } while (0)
#define PG8_WAIT_V(n) asm volatile("s_waitcnt vmcnt(" #n ")" ::: "memory")
#define PG8_WAIT_L(n) asm volatile("s_waitcnt lgkmcnt(" #n ")" ::: "memory")
#define PG8_BAR __builtin_amdgcn_s_barrier()
#define PG8_SCHED __builtin_amdgcn_sched_barrier(0)
#define PG8_KA(base, t) ((base) + (long)(t) * kstep + ((t) >= tseg ? segoff : 0L))
#define PG8_KB(base, t) ((base) + (long)(t) * kstep + ((t) >= tseg ? segoffB : 0L))
    Unit cur, nxt; int ui = 0;
    if (!uf(0, cur)) return;
    f32x4 acc[2][2][4][2];
#pragma unroll
    for (int a = 0; a < 2; ++a)
#pragma unroll
        for (int b = 0; b < 2; ++b)
#pragma unroll
            for (int m = 0; m < 4; ++m)
#pragma unroll
                for (int n = 0; n < 2; ++n) acc[a][b][m][n] = (f32x4){0.f, 0.f, 0.f, 0.f};
    bf16x8 At[4][2], B0[2][2], B1[2][2];
    const unsigned char* cA = cur.A; const unsigned char* cB = cur.B;
    PG8_STAGE(PG8_SB(0, 0), cB, voffB); PG8_STAGE(PG8_SA(0, 0), cA, voffA); PG8_STAGE(PG8_SB(0, 1), cB + hstepB, voffB); PG8_STAGE(PG8_SA(0, 1), cA + hstepA, voffA);
    if (wr == 1) PG8_BAR;
    PG8_WAIT_V(4); PG8_BAR;
    PG8_STAGE(PG8_SB(1, 0), PG8_KB(cB, 1), voffB); PG8_STAGE(PG8_SA(1, 0), PG8_KA(cA, 1), voffA); PG8_STAGE(PG8_SB(1, 1), PG8_KB(cB, 1) + hstepB, voffB);
    PG8_WAIT_V(6); PG8_BAR;
    for (;;) {
        const bool has_next = uf(ui + 1, nxt);
        const unsigned char* nA = has_next ? nxt.A : cA; const unsigned char* nB = has_next ? nxt.B : cB;
        for (int t = 0; t < nt; t += 2) {
            const bool last = (t == nt - 2);
            const unsigned char* a1 = PG8_KA(cA, t + 1);
            const unsigned char* a2 = last ? nA : PG8_KA(cA, t + 2); const unsigned char* b2 = last ? nB : PG8_KB(cB, t + 2);
            const unsigned char* a3 = last ? PG8_KA(nA, 1) : PG8_KA(cA, t + 3); const unsigned char* b3 = last ? PG8_KB(nB, 1) : PG8_KB(cB, t + 3);
            PG8_LDB(B0, 0, 0); PG8_SCHED; PG8_LDA(At, 0, 0); PG8_STAGE(PG8_SA(1, 1), a1 + hstepA, voffA);
            PG8_WAIT_L(8); PG8_BAR; PG8_WAIT_L(0); PG8_MMA(0, 0, At, B0); PG8_BAR; PG8_SCHED;
            PG8_LDB(B1, 0, 1); PG8_STAGE(PG8_SB(0, 0), b2, voffB);
            PG8_BAR; PG8_WAIT_L(0); PG8_MMA(0, 1, At, B1); PG8_BAR;
            PG8_LDA(At, 0, 1); PG8_STAGE(PG8_SA(0, 0), a2, voffA);
            PG8_BAR; PG8_WAIT_L(0); PG8_MMA(1, 0, At, B0); PG8_BAR; PG8_SCHED;
            PG8_STAGE(PG8_SB(0, 1), b2 + hstepB, voffB);
            PG8_WAIT_V(6); PG8_BAR; PG8_MMA(1, 1, At, B1); PG8_BAR;
            PG8_LDB(B0, 1, 0); PG8_SCHED; PG8_LDA(At, 1, 0); PG8_STAGE(PG8_SA(0, 1), a2 + hstepA, voffA);
            PG8_WAIT_L(8); PG8_BAR; PG8_WAIT_L(0); PG8_MMA(0, 0, At, B0); PG8_BAR; PG8_SCHED;
            PG8_LDB(B1, 1, 1); PG8_STAGE(PG8_SB(1, 0), b3, voffB);
            PG8_BAR; PG8_WAIT_L(0); PG8_MMA(0, 1, At, B1); PG8_BAR;
            PG8_LDA(At, 1, 1); PG8_STAGE(PG8_SA(1, 0), a3, voffA);
            PG8_BAR; PG8_WAIT_L(0); PG8_MMA(1, 0, At, B0); PG8_BAR; PG8_SCHED;
            PG8_STAGE(PG8_SB(1, 1), b3 + hstepB, voffB);
            PG8_WAIT_V(6); PG8_BAR; PG8_MMA(1, 1, At, B1); PG8_BAR;
        }
        E(acc, cur, wr, wc, fr, fq);
        if (!has_next) break;
#pragma unroll
        for (int a = 0; a < 2; ++a)
#pragma unroll
            for (int b = 0; b < 2; ++b)
#pragma unroll
                for (int m = 0; m < 4; ++m)
#pragma unroll
                    for (int n = 0; n < 2; ++n) acc[a][b][m][n] = (f32x4){0.f, 0.f, 0.f, 0.f};
        cur = nxt; cA = nA; cB = nB; ++ui;
    }
    PG8_WAIT_V(0);
    if (wr == 0) PG8_BAR;
    PG8_BAR;
#undef PG8_SA
#undef PG8_SB
#undef PG8_STAGE
#undef PG8_LDA
#undef PG8_LDB
#undef PG8_MMA
#undef PG8_WAIT_V
#undef PG8_WAIT_L
#undef PG8_BAR
#undef PG8_SCHED
#undef PG8_KA
#undef PG8_KB
}

struct EpiBf16 {
    __device__ __forceinline__ void operator()(const f32x4 (&acc)[2][2][4][2], const Unit& u, int wr, int wc, int fr, int fq) const {
        if (u.kind == 1) {
            if (wc < 2) {
#pragma unroll
                for (int ai = 0; ai < 2; ++ai)
#pragma unroll
                    for (int m = 0; m < 4; ++m) { float* rowp = (float*)(u.O + (size_t)(ai * 128 + wr * 64 + m * 16 + fr) * u.ldo) + wc * 32 + 8 * fq;
                        *(f32x4*)(rowp) = acc[ai][0][m][0]; *(f32x4*)(rowp + 4) = acc[ai][0][m][1]; }
            }
            return;
        }
        const bool gate = (u.kind == 2);
#pragma unroll
        for (int ai = 0; ai < 2; ++ai)
#pragma unroll
            for (int m = 0; m < 4; ++m) {
                const size_t ro = (size_t)(ai * 128 + wr * 64 + m * 16 + fr) * u.ldo + (size_t)(wc * 32 + 8 * fq) * 2;
#pragma unroll
                for (int bj = 0; bj < 2; ++bj) { f32x4 v0 = acc[ai][bj][m][0], v1 = acc[ai][bj][m][1];
                    if (gate) { const u32x4 z = *(const u32x4*)(u.X + ro + bj * 256);
                        v0[0] *= u.scale * silu_f(bflo(z.x)); v0[1] *= u.scale * silu_f(bfhi(z.x)); v0[2] *= u.scale * silu_f(bflo(z.y)); v0[3] *= u.scale * silu_f(bfhi(z.y));
                        v1[0] *= u.scale * silu_f(bflo(z.z)); v1[1] *= u.scale * silu_f(bfhi(z.z)); v1[2] *= u.scale * silu_f(bflo(z.w)); v1[3] *= u.scale * silu_f(bfhi(z.w)); }
                    u32x4 w; w.x = cvt_pk(v0[0], v0[1]); w.y = cvt_pk(v0[2], v0[3]); w.z = cvt_pk(v1[0], v1[1]); w.w = cvt_pk(v1[2], v1[3]);
                    *(u32x4*)(u.O + ro + bj * 256) = w; }
            }
    }
};
template <bool HALF> struct EpiResT {
    __device__ __forceinline__ void operator()(const f32x4 (&acc)[2][2][4][2], const Unit& u, int wr, int wc, int fr, int fq) const {
        f32x4 gv[2][2];
#pragma unroll
        for (int bj = 0; bj < 2; ++bj)
#pragma unroll
            for (int n = 0; n < 2; ++n) gv[bj][n] = *(const f32x4*)(u.G + bj * 128 + wc * 32 + n * 16 + 4 * fq);
#pragma unroll
        for (int ai = 0; ai < (HALF ? 1 : 2); ++ai)
#pragma unroll
            for (int m = 0; m < 4; ++m) {
                const size_t ro = (size_t)(ai * 128 + wr * 64 + m * 16 + fr) * 4096 + (size_t)(wc * 32 + 4 * fq) * 4;
#pragma unroll
                for (int bj = 0; bj < 2; ++bj)
#pragma unroll
                    for (int n = 0; n < 2; ++n) { const size_t o = ro + (size_t)(bj * 128 + n * 16) * 4;
                        const f32x4 xo = *(const f32x4*)(u.X + o); *(f32x4*)(u.O + o) = xo + gv[bj][n] * acc[ai][bj][m][n]; }
            }
    }
};

typedef EpiResT<false> EpiRes;
__device__ void phase_prep0(const P& p, unsigned char* sm) {
    const int tid = otid(), G = gridDim.x, bid = blockIdx.x;
    float* sact = (float*)sm; float* red = sact + 9 * 1024;
    for (int i = tid; i < 9 * 1024; i += 512) { const int ci = i >> 10, k = i & 1023; const float v = ci == 0 ? p.c_ctx[k] : p.c[(ci - 1) * 1024 + k]; sact[i] = silu_f(v); }
    __syncthreads();
    float* MOD = (float*)(p.ws + WS_MOD);
    for (int u = bid; u < 192; u += G) {
        const int layer = u / 48, cb = u % 48, kq = tid >> 6, cl = tid & 63, col = cb * 64 + cl;
        float a0 = 0, a1 = 0, a2 = 0, a3 = 0, a4 = 0, a5 = 0, a6 = 0, a7 = 0, a8 = 0;
        const float* w = p.w_mod + ((size_t)layer * 1024 + kq * 128) * 3072 + col; const float* sa = sact + kq * 128;
#pragma unroll 16
        for (int k = 0; k < 128; ++k) { const float wv = w[(size_t)k * 3072];
            a0 += sa[k] * wv; a1 += sa[1024 + k] * wv; a2 += sa[2048 + k] * wv; a3 += sa[3072 + k] * wv; a4 += sa[4096 + k] * wv;
            a5 += sa[5120 + k] * wv; a6 += sa[6144 + k] * wv; a7 += sa[7168 + k] * wv; a8 += sa[8192 + k] * wv; }
        float* rr = red + kq * 576 + cl;
        rr[0] = a0; rr[64] = a1; rr[128] = a2; rr[192] = a3; rr[256] = a4; rr[320] = a5; rr[384] = a6; rr[448] = a7; rr[512] = a8;
        __syncthreads();
        for (int o = tid; o < 576; o += 512) { const int ci = o >> 6, c2 = cb * 64 + (o & 63); float s = 0;
            for (int q = 0; q < 8; ++q) s += red[q * 576 + o];
            MOD[(ci * 4 + layer) * 3072 + c2] = s + p.b_mod[layer * 3072 + c2]; }
        __syncthreads();
    }
    const long gt = (long)bid * 512 + tid, gn = (long)G * 512;
    const float TWO_PI = 6.283185307179586f;
    for (long i = gt; i < 512 * 256 / 8; i += gn) { const int j = (int)(i >> 5), c0 = (int)(i & 31) * 8, m = j >> 1, part = j & 1; float v[8];
#pragma unroll
        for (int e = 0; e < 8; ++e) { const float ang = (float)((m * (c0 + e)) & 255) * (TWO_PI / 256.f); v[e] = j == 1 ? (((c0 + e) & 1) ? -1.f : 1.f) : (part ? -__sinf(ang) : __cosf(ang)); }
        u32x4 w; w.x = cvt_pk(v[0], v[1]); w.y = cvt_pk(v[2], v[3]); w.z = cvt_pk(v[4], v[5]); w.w = cvt_pk(v[6], v[7]);
        *(u32x4*)(p.ws + WS_TC + (size_t)i * 16) = w; }
    for (long i = gt; i < 256 * 512 / 8; i += gn) { const int k = (int)(i >> 6), kk0 = (int)(i & 63) * 8, part = kk0 >> 8, l0 = kk0 & 255; float v[8];
#pragma unroll
        for (int e = 0; e < 8; ++e) { const float ang = (float)((k * (l0 + e)) & 255) * (TWO_PI / 256.f); v[e] = part ? __sinf(ang) : __cosf(ang); }
        u32x4 w; w.x = cvt_pk(v[0], v[1]); w.y = cvt_pk(v[2], v[3]); w.z = cvt_pk(v[4], v[5]); w.w = cvt_pk(v[6], v[7]);
        *(u32x4*)(p.ws + WS_ALC + (size_t)i * 16) = w; }
    for (long i = gt; i < 2048L * 2048 / 8; i += gn) { const int k = (int)(i >> 8), kk0 = (int)(i & 255) * 8, part = kk0 >> 10, l0 = kk0 & 1023; float v[8];
#pragma unroll
        for (int e = 0; e < 8; ++e) { const int l = l0 + e; const float ang = (float)((k * l) & 2047) * (TWO_PI / 2048.f);
            v[e] = part ? (l == 0 ? ((k & 1) ? -1.f : 1.f) : __sinf(ang)) : __cosf(ang); }
        u32x4 w; w.x = cvt_pk(v[0], v[1]); w.y = cvt_pk(v[2], v[3]); w.z = cvt_pk(v[4], v[5]); w.w = cvt_pk(v[6], v[7]);
        *(u32x4*)(slot_ptr(p, k >> 9, 1) + ((size_t)(k & 511) * 2048 + kk0) * 2) = w; }
    for (long i = gt; i < 2L * 1024 * 1024 / 8; i += gn) { const int e = (int)(i >> 17), d = (int)(i >> 7) & 1023, c0 = (int)(i & 127) * 8;
        const float* src = p.fc_w_in + ((size_t)e * 1024 + d) * 6144 + c0; const f32x4 x0 = *(const f32x4*)src, x1 = *(const f32x4*)(src + 4);
        u32x4 w; w.x = cvt_pk(x0[0], x0[1]); w.y = cvt_pk(x0[2], x0[3]); w.z = cvt_pk(x1[0], x1[1]); w.w = cvt_pk(x1[2], x1[3]);
        *(u32x4*)(p.ws + WS_WUBF + (size_t)i * 16) = w; }
}

struct UF_Prep1 { unsigned char* ws; int G, c;
    __device__ __forceinline__ bool operator()(int i, Unit& u) const { const int L = i * G + c; if (L >= 64) return false;
        const int e = L >> 5, g = (L >> 3) & 3, pm = (L >> 2) & 1, pn = L & 3;
        u.A = ws + WS_TC + (size_t)pm * 256 * 512; u.B = ws + WS_WUBF + (((size_t)e * 1024 + pn * 256) * 1024 + g * 256) * 2;
        u.O = ws + WS_WF + (((size_t)e * 2048 + g * 512 + pm * 256) * 1024 + pn * 256) * 2; u.ldo = 2048; u.kind = 0; u.X = nullptr; u.G = nullptr; u.scale = 1.f; return true; } };

template <class RowPtr>
__device__ __forceinline__ void conv_tiles4(const float* W, int ldw, int k0, int n0, int nvalid  , const RowPtr& rowptr, float* sT) {
    const int tid = otid();
#pragma unroll
    for (int j = 0; j < 4; ++j)
#pragma unroll
        for (int i = 0; i < 8; ++i) { const int e = tid + i * 512, kk = e >> 6, nn = e & 63, n = n0 + j * 64 + nn;
            sT[j * 4160 + kk * 65 + nn] = n < nvalid ? W[(size_t)(k0 + kk) * ldw + n] : 0.f; }
    __syncthreads();
    { const int nn = tid >> 3, kc = (tid & 7) * 8;
#pragma unroll
      for (int j = 0; j < 4; ++j) { float v[8];
#pragma unroll
          for (int i = 0; i < 8; ++i) v[i] = sT[j * 4160 + (kc + i) * 65 + nn];
          u32x4 w; w.x = cvt_pk(v[0], v[1]); w.y = cvt_pk(v[2], v[3]); w.z = cvt_pk(v[4], v[5]); w.w = cvt_pk(v[6], v[7]);
          *(u32x4*)(rowptr(n0 + j * 64 + nn) + (size_t)(k0 + kc) * 2) = w; } }
    __syncthreads();
}

__device__ void norm_rows(const P& p, int layer, int tok_lo, int ntok, unsigned char* hm) {
    const int tid = otid(), lane = tid & 63, gw = blockIdx.x * 8 + (tid >> 6), nw = gridDim.x * 8;
    const float* MOD = (const float*)(p.ws + WS_MOD);
    const float* ng = p.norm_g + layer * 1024;
    const int rpw = (ntok + nw - 1) / nw, r_lo = gw * rpw, r_hi = r_lo + rpw < ntok ? r_lo + rpw : ntok;
    f32x4 gs[4], shv[4]; int cur_cond = -1;
#pragma unroll
    for (int i = 0; i < 4; ++i) { gs[i] = (f32x4){0.f, 0.f, 0.f, 0.f}; shv[i] = gs[i]; }
    for (int t0 = r_lo; t0 < r_hi; t0 += 4) {
        f32x4 v[4][4]; float ss[4];
#pragma unroll
        for (int j = 0; j < 4; ++j) { const int t = t0 + j < r_hi ? t0 + j : r_hi - 1, tok = tok_lo + t;
            const float* xr = layer == 0 ? (tok < TOKC ? p.x_prompt + (size_t)tok * 1024 : p.x_sample + (size_t)(tok - TOKC) * 1024) : p.out + (size_t)tok * 1024;
#pragma unroll
            for (int i = 0; i < 4; ++i) v[j][i] = *(const f32x4*)(xr + i * 256 + lane * 4); }
#pragma unroll
        for (int j = 0; j < 4; ++j) { float a = 0.f;
#pragma unroll
            for (int i = 0; i < 4; ++i) a += v[j][i][0] * v[j][i][0] + v[j][i][1] * v[j][i][1] + v[j][i][2] * v[j][i][2] + v[j][i][3] * v[j][i][3];
            ss[j] = a; }
#pragma unroll
        for (int o = 32; o >= 1; o >>= 1) {
#pragma unroll
            for (int j = 0; j < 4; ++j) ss[j] += __shfl_xor(ss[j], o); }
#pragma unroll
        for (int j = 0; j < 4; ++j) if (t0 + j < r_hi) { const int t = t0 + j, tok = tok_lo + t;
            const float rstd = rsqrtf(ss[j] * (1.0f / 1024.f) + 1e-6f);
            const int cond = cond_of_tok(tok);
            if (cond != cur_cond) { cur_cond = cond; const float* md = MOD + (size_t)(cond * 4 + layer) * 3072;
#pragma unroll
                for (int i = 0; i < 4; ++i) { const int col = i * 256 + lane * 4; const f32x4 g = *(const f32x4*)(ng + col), sc = *(const f32x4*)(md + 1024 + col);
                    shv[i] = *(const f32x4*)(md + col);
#pragma unroll
                    for (int e = 0; e < 4; ++e) gs[i][e] = g[e] * (1.0f + sc[e]); } }
#pragma unroll
            for (int i = 0; i < 4; ++i) { const int col = i * 256 + lane * 4; f32x4 y;
#pragma unroll
                for (int e = 0; e < 4; ++e) y[e] = (v[j][i][e] * rstd) * gs[i][e] + shv[i][e];
                u32x2 w; w.x = cvt_pk(y[0], y[1]); w.y = cvt_pk(y[2], y[3]);
                *(u32x2*)(hm + ((size_t)t * 1024 + col) * 2) = w; } }
    }
}

__device__ void conv_even(const P& p, unsigned char* sm, int layer, int rank, int nblk) {
    const int e = layer >> 1;
    {
        float* sT = (float*)sm;
        const P* pp = &p;
        for (int t = rank; t < 320 + 128; t += nblk) {
            if (t < 320) { const int kt = t & 15, n0 = (t >> 4) * 256;
                conv_tiles4(p.fc_w_in + (size_t)e * 1024 * 6144 + 1024, 6144, kt * 64, n0, 5120, [pp](int n) { return slot_ptr(*pp, 8 + (n >> 10), 1) + (size_t)(n & 1023) * 2048; }, sT);
            } else { const int t2 = t - 320, kt = t2 & 31, n0 = (t2 >> 5) * 256;
                conv_tiles4(p.fc_w_out + (size_t)e * 2048 * 1024, 1024, kt * 64, n0, 1024, [pp](int n) { return slot_ptr(*pp, 13 + (n >> 9), 1) + (size_t)(n & 511) * 4096; }, sT); }
        }
    }
}
__device__ void phase_normE(const P& p, unsigned char* sm, int layer, int pass) {
    if (pass == 0 && layer == 0) conv_even(p, sm, layer, blockIdx.x, gridDim.x);
    norm_rows(p, layer, pass ? E_T0 * 256 : 0, (pass ? E_T1 : E_T0) * 256, p.ws + E_HM);
}
struct UF_G1E { const P* p; int e, pass, G, c;
    __device__ __forceinline__ bool operator()(int i, Unit& u) const { int L = i * G + c; const int nt = pass ? E_T1 : E_T0, t0 = pass ? E_T0 : 0; if (L >= nt * 24) return false;
        unsigned char* ws = p->ws; int pm, pn; u.kind = 0; u.X = nullptr; u.G = nullptr; u.scale = 1.f;
        if (L < nt * 20) { tile_order(L, nt, 20, pm, pn);
            u.A = ws + E_HM + (size_t)pm * 256 * 2048; u.B = slot_ptr(*p, 8 + (pn >> 2), 1) + (size_t)(pn & 3) * 256 * 2048; u.ldo = 2048;
            if (pn < 4) u.O = ws + E_ZA + (((size_t)(t0 + pm) * 256) * 1024 + pn * 256) * 2;
            else u.O = ws + E_PL + (size_t)((pn - 4) >> 2) * E_PS + ((size_t)pm * 256 * 1024 + (pn & 3) * 256) * 2;
        } else { L -= nt * 20; tile_order(L, 4, nt, pm, pn);
            u.A = ws + WS_WF + ((size_t)e * 2048 + pm * 512) * 2048; u.B = ws + E_HM + (size_t)pn * 256 * 2048;
            const int g = pm, j0 = 0, tg = t0 + pn;
            if (tg < 16) { u.O = ws + E_VTC + (((size_t)(tg * 4 + g) * 512 + j0) * 256) * 2; u.ldo = 512; }
            else { const int t2 = tg - 16, b = t2 >> 3, l0 = (t2 & 7) * 256; u.O = ws + E_VTL + (((size_t)(b * 4 + g) * 512 + j0) * 2048 + l0) * 2; u.ldo = 4096; }
        }
        return true; } };
__device__ __forceinline__ void up8(const u32x4 a, const u32x4 b, float (&o)[8]) {
    o[0] = bflo(a.x) * bflo(b.x); o[1] = bfhi(a.x) * bfhi(b.x); o[2] = bflo(a.y) * bflo(b.y); o[3] = bfhi(a.y) * bfhi(b.y);
    o[4] = bflo(a.z) * bflo(b.z); o[5] = bfhi(a.z) * bfhi(b.z); o[6] = bflo(a.w) * bflo(b.w); o[7] = bfhi(a.w) * bfhi(b.w); }
__device__ void phase_e3(const P& p, int layer, int pass) {
    const int e = layer >> 1;
    const long gt = (long)blockIdx.x * 512 + otid(), gn = (long)gridDim.x * 512;
    const unsigned char* PL = p.ws + E_PL; const size_t PS = E_PS; const int tok_lo = pass ? E_T0 * 256 : 0, nstrip = (pass ? E_T1 : E_T0) * 64;
    const float* cw = p.fc_conv_w + (size_t)e * 3 * 1024;
    for (long it = gt; it < (long)nstrip * 128; it += gn) {
        const int tl = (int)(it >> 7) * 4, c8 = (int)(it & 127) * 8, tok = tok_lo + tl;
        const int rl = tok < TOKC ? 256 : 64, pos = tok & (rl - 1);
        const size_t o = ((size_t)tl * 1024 + c8) * 2;
        float cv[6][8];
        const u32x4 zero = {0, 0, 0, 0};
#pragma unroll
        for (int j = 0; j < 6; ++j) { const bool ok = (j == 0) ? (pos > 0) : (j == 5 ? (pos + 4 < rl) : true);
            const u32x4 cc = ok ? *(const u32x4*)(PL + PS + o + (long)(j - 1) * 2048) : zero, vv = ok ? *(const u32x4*)(PL + 2 * PS + o + (long)(j - 1) * 2048) : zero;
            up8(cc, vv, cv[j]); }
        float w0[8], w1[8], w2[8];
        { const f32x4 a0 = *(const f32x4*)(cw + c8), a1 = *(const f32x4*)(cw + c8 + 4), b0 = *(const f32x4*)(cw + 1024 + c8), b1 = *(const f32x4*)(cw + 1024 + c8 + 4),
                      c0 = *(const f32x4*)(cw + 2048 + c8), c1 = *(const f32x4*)(cw + 2048 + c8 + 4);
#pragma unroll
          for (int j = 0; j < 4; ++j) { w0[j] = a0[j]; w0[4 + j] = a1[j]; w1[j] = b0[j]; w1[4 + j] = b1[j]; w2[j] = c0[j]; w2[4 + j] = c1[j]; } }
#pragma unroll
        for (int t = 0; t < 4; ++t) {
            const u32x4 bv = *(const u32x4*)(PL + o + (size_t)t * 2048), zv = *(const u32x4*)(PL + 3 * PS + o + (size_t)t * 2048);
            float bz[8];
            bz[0] = bflo(bv.x) * silu_f(bflo(zv.x)); bz[1] = bfhi(bv.x) * silu_f(bfhi(zv.x)); bz[2] = bflo(bv.y) * silu_f(bflo(zv.y)); bz[3] = bfhi(bv.y) * silu_f(bfhi(zv.y));
            bz[4] = bflo(bv.z) * silu_f(bflo(zv.z)); bz[5] = bfhi(bv.z) * silu_f(bfhi(zv.z)); bz[6] = bflo(bv.w) * silu_f(bflo(zv.w)); bz[7] = bfhi(bv.w) * silu_f(bfhi(zv.w));
            float r[8];
#pragma unroll
            for (int j = 0; j < 8; ++j) r[j] = bz[j] * (w0[j] * cv[t][j] + w1[j] * cv[t + 1][j] + w2[j] * cv[t + 2][j]);
            u32x4 w; w.x = cvt_pk(r[0], r[1]); w.y = cvt_pk(r[2], r[3]); w.z = cvt_pk(r[4], r[5]); w.w = cvt_pk(r[6], r[7]);
            *(u32x4*)(p.ws + E_YB + ((size_t)(tok + t) * 1024 + c8) * 2) = w;
        }
    }
    if (pass == 1) {
        unsigned short* VT = (unsigned short*)(p.ws + E_VTL);
        for (long it = gt; it < 32L * 128 * 128; it += gn) {
            const int l0 = (int)(it & 127) * 8, m = (int)(it >> 7) & 127; const long slice = it >> 14;
            unsigned short* base = VT + (size_t)slice * 512 * 2048;
            unsigned short* vr = base + (size_t)(2 * m) * 2048; unsigned short* vi = vr + 2048;
            const u32x4 a = *(const u32x4*)(vr + l0), b = *(const u32x4*)(vi + l0);
            const u32x4 ma = *(const u32x4*)(vr + 2040 - l0), mb = *(const u32x4*)(vi + 2040 - l0);
            float x0r, x0i;
            if (l0 == 0) { x0r = 0.f; x0i = 0.f; } else { x0r = bf2f((short)vr[2048 - l0]); x0i = bf2f((short)vi[2048 - l0]); }
            const float ny_r = bf2f((short)vr[1024]), ny_i = bf2f((short)vi[1024]);
            float er[8], eo[8];
            float es[8];
            er[0] = bflo(a.x) + x0r;        eo[0] = bflo(b.x) - x0i;        es[0] = bflo(b.x) + x0i;
            er[1] = bfhi(a.x) + bfhi(ma.w); eo[1] = bfhi(b.x) - bfhi(mb.w); es[1] = bfhi(b.x) + bfhi(mb.w);
            er[2] = bflo(a.y) + bflo(ma.w); eo[2] = bflo(b.y) - bflo(mb.w); es[2] = bflo(b.y) + bflo(mb.w);
            er[3] = bfhi(a.y) + bfhi(ma.z); eo[3] = bfhi(b.y) - bfhi(mb.z); es[3] = bfhi(b.y) + bfhi(mb.z);
            er[4] = bflo(a.z) + bflo(ma.z); eo[4] = bflo(b.z) - bflo(mb.z); es[4] = bflo(b.z) + bflo(mb.z);
            er[5] = bfhi(a.z) + bfhi(ma.y); eo[5] = bfhi(b.z) - bfhi(mb.y); es[5] = bfhi(b.z) + bfhi(mb.y);
            er[6] = bflo(a.w) + bflo(ma.y); eo[6] = bflo(b.w) - bflo(mb.y); es[6] = bflo(b.w) + bflo(mb.y);
            er[7] = bfhi(a.w) + bfhi(ma.x); eo[7] = bfhi(b.w) - bfhi(mb.x); es[7] = bfhi(b.w) + bfhi(mb.x);
            u32x4 w; w.x = cvt_pk(er[0], er[1]); w.y = cvt_pk(er[2], er[3]); w.z = cvt_pk(er[4], er[5]); w.w = cvt_pk(er[6], er[7]);
            if (m != 0) {
                if (l0 == 0) eo[0] = ny_r;
                u32x4 z; z.x = cvt_pk(eo[0], eo[1]); z.y = cvt_pk(eo[2], eo[3]); z.z = cvt_pk(eo[4], eo[5]); z.w = cvt_pk(eo[6], eo[7]);
                u32x4 zn; zn.x = cvt_pk(l0 == 0 ? ny_r : -eo[0], -eo[1]); zn.y = cvt_pk(-eo[2], -eo[3]); zn.z = cvt_pk(-eo[4], -eo[5]); zn.w = cvt_pk(-eo[6], -eo[7]);
                *(u32x4*)(vr + l0) = w; *(u32x4*)(vi + l0) = z;
                unsigned short* wr = base + (size_t)(2 * (256 - m)) * 2048;
                *(u32x4*)(wr + l0) = w; *(u32x4*)(wr + 2048 + l0) = zn;
            } else {
                u32x4 z0 = {0u, 0u, 0u, 0u}, z128 = {0u, 0u, 0u, 0u};
                if (l0 == 0) { z0.x = cvt_pk(ny_r, 0.f); z128.x = cvt_pk(ny_i, 0.f); es[0] = bflo(b.x); }
                u32x4 w128; w128.x = cvt_pk(es[0], es[1]); w128.y = cvt_pk(es[2], es[3]); w128.z = cvt_pk(es[4], es[5]); w128.w = cvt_pk(es[6], es[7]);
                *(u32x4*)(vr + l0) = w; *(u32x4*)(vi + l0) = z0;
                unsigned short* wr = base + (size_t)256 * 2048;
                *(u32x4*)(wr + l0) = w128; *(u32x4*)(wr + 2048 + l0) = z128;
            }
        }
        unsigned short* VC = (unsigned short*)(p.ws + E_VTC);
        for (long it = gt; it < 64L * 128 * 32; it += gn) {
            const int l0 = (int)(it & 31) * 8, m = (int)(it >> 5) & 127; const long slice = it >> 12;
            unsigned short* base = VC + (size_t)slice * 512 * 256;
            const u32x4 a = *(const u32x4*)(base + (size_t)(2 * m) * 256 + l0), b = *(const u32x4*)(base + (size_t)(2 * m + 1) * 256 + l0);
            if (m != 0) { u32x4 bn; bn.x = b.x ^ 0x80008000u; bn.y = b.y ^ 0x80008000u; bn.z = b.z ^ 0x80008000u; bn.w = b.w ^ 0x80008000u;
                unsigned short* wr = base + (size_t)(2 * (256 - m)) * 256; *(u32x4*)(wr + l0) = a; *(u32x4*)(wr + 256 + l0) = bn;
            } else { const u32x4 z = {0u, 0u, 0u, 0u};
                unsigned short* wr = base + (size_t)256 * 256; *(u32x4*)(wr + l0) = b; *(u32x4*)(wr + 256 + l0) = z; *(u32x4*)(base + 256 + l0) = z; }
        }
    }
}
struct UF_E4L { const P* p; int G, c;
    __device__ __forceinline__ bool operator()(int i, Unit& u) const { const int L = i * G + c; if (L >= 256) return false;
        const int xcd = L & 7, j = L >> 3, sl = xcd + 8 * (j >> 3), pm = j & 7, g = sl & 3, b = sl >> 2; unsigned char* ws = p->ws;
        u.A = slot_ptr(*p, pm >> 1, 1) + (size_t)(pm & 1) * 256 * 4096; u.B = ws + E_VTL + (size_t)(b * 4 + g) * 512 * 2048 * 2;
        const size_t o = (((size_t)TOKC + b * 2048 + pm * 256) * 1024 + g * 256) * 2;
        u.O = ws + E_YA + o; u.X = ws + E_ZA + o; u.ldo = 2048; u.kind = 2; u.G = nullptr; u.scale = 0.0013810679320049757f; return true; } };
struct UF_E4C { const P* p; int G, c;
    __device__ __forceinline__ bool operator()(int i, Unit& u) const { const int L = i * G + c; if (L >= 64) return false;
        const int g = L & 3, b = L >> 2; unsigned char* ws = p->ws;
        u.A = ws + WS_ALC; u.B = ws + E_VTC + (size_t)(b * 4 + g) * 512 * 256 * 2;
        const size_t o = (((size_t)b * 256) * 1024 + g * 256) * 2;
        u.O = ws + E_YA + o; u.X = ws + E_ZA + o; u.ldo = 2048; u.kind = 2; u.G = nullptr; u.scale = 0.00390625f; return true; } };
struct UF_G2 { const P* p; int layer, sub, G, c;
    __device__ __forceinline__ bool operator()(int i, Unit& u) const { const int L = i * G + c; int pm, pn, row0;
        if (sub == 0) { if (L >= 256) return false; tile_order(L, 64, 4, pm, pn); row0 = pm * 256; }
        else { if (L >= 128) return false; tile_order(L, 32, 4, pm, pn); row0 = 16384 + pm * 128; }
        unsigned char* ws = p->ws; const bool even = (layer & 1) == 0;
        if (even) { u.A = ws + E_YA + (size_t)row0 * 2048; u.B = slot_ptr(*p, 13 + (pn >> 1), 1) + (size_t)(pn & 1) * 256 * 4096; }
        else { u.A = ws + O_YN + (size_t)row0 * 4096; u.B = ws + O_WOUT + (size_t)pn * 256 * 4096; }
        const size_t o = ((size_t)row0 * 1024 + pn * 256);
        u.O = (unsigned char*)(p->out + o);
        u.X = layer == 0 ? (const unsigned char*)((row0 < TOKC ? p->x_prompt + (size_t)row0 * 1024 : p->x_sample + (size_t)(row0 - TOKC) * 1024) + pn * 256) : (const unsigned char*)(p->out + o);
        u.G = (const float*)(ws + WS_MOD) + (size_t)(cond_of_tok(row0) * 4 + layer) * 3072 + 2048 + pn * 256;
        u.ldo = 4096; u.kind = 0; u.scale = 1.f; return true; } };

__device__ void conv_odd(const P& p, unsigned char* sm, int layer, int rank, int nblk) {
    const int li = layer >> 1; float* sT = (float*)sm; unsigned char* ws = p.ws;
    for (int t = rank; t < 400 + 128; t += nblk) {
        if (t < 400) { const int kt = t & 15, n0 = (t >> 4) * 256;
            conv_tiles4(p.ssd_w_in + (size_t)li * 1024 * 6208, 6208, kt * 64, n0, 6208, [ws](int n) { return ws + O_WIN + (size_t)n * 2048; }, sT);
        } else { const int t2 = t - 400, kt = t2 & 31, n0 = (t2 >> 5) * 256;
            conv_tiles4(p.ssd_w_out + (size_t)li * 2048 * 1024, 1024, kt * 64, n0, 1024, [ws](int n) { return ws + O_WOUT + (size_t)n * 4096; }, sT); }
    }
}
__device__ void phase_normO(const P& p, unsigned char* sm, int layer) {
    norm_rows(p, layer, 0, TOK, p.ws + O_HM);
}
struct UF_G1O { unsigned char* ws; int pass, nq, G, c;
    __device__ __forceinline__ bool operator()(int i, Unit& u) const { const int L = i * G + c; if (L >= 80 * nq) return false;
        int pm, q; tile_order(L, 80, nq, pm, q); u.kind = 0; u.X = nullptr; u.G = nullptr; u.scale = 1.f;
        u.A = ws + O_HM + (size_t)pm * 256 * 2048;
        int nrow;
        if (q < 2) { nrow = 512 * pass + 256 * q; u.O = ws + O_Z + ((size_t)pm * 256 * 512 + q * 256) * 2; u.ldo = 1024; }
        else if (q < 4) { nrow = 2048 + 512 * pass + 256 * (q - 2); u.O = ws + O_RAWX + ((size_t)pm * 256 * 512 + (q - 2) * 256) * 2; u.ldo = 1024; }
        else if (q == 4) { nrow = 4096 + 256 * pass; u.O = ws + O_RAWB + (size_t)pm * 256 * 256 * 2; u.ldo = 512; }
        else if (q == 5) { nrow = 5120 + 256 * pass; u.O = ws + O_RAWC + (size_t)pm * 256 * 256 * 2; u.ldo = 512; }
        else { nrow = 6144; u.O = ws + O_DTR + (size_t)pm * 256 * 64 * 4; u.ldo = 256; u.kind = 1; }
        u.B = ws + O_WIN + (size_t)nrow * 2048; return true; } };

struct O3Tile { const unsigned char* src; unsigned char* dstN; unsigned char* dstT; int lds_, cch, ch0, ldn; };
__device__ __forceinline__ O3Tile o3_decode(unsigned char* ws, int ct, int pass) {
    O3Tile t; t.dstN = nullptr; t.dstT = nullptr; t.ldn = 512;
    if (ct < 8) { t.ch0 = ct * 64; t.src = ws + O_RAWX; t.lds_ = 1024; t.cch = 512 * pass + t.ch0; t.dstN = ws + O_XT; t.ldn = 1024; }
    else if (ct < 12) { t.ch0 = (ct - 8) * 64; t.src = ws + O_RAWB; t.lds_ = 512; t.cch = 2048 + 256 * pass + t.ch0; t.dstN = ws + O_BS; }
    else { t.ch0 = (ct - 12) * 64; t.src = ws + O_RAWC; t.lds_ = 512; t.cch = 3072 + 256 * pass + t.ch0; t.dstN = ws + O_CS; }
    return t;
}
__device__ __forceinline__ void o3_load(const O3Tile& t, int tok, int c8, u32x4& x0, u32x4& xm, u32x4& xp) {
    const int L = tok < TOKC ? 256 : 2048, pos = tok < TOKC ? (tok & 255) : ((tok - TOKC) & 2047);
    const unsigned char* sp = t.src + (size_t)tok * t.lds_ + (size_t)(t.ch0 + c8) * 2;
    x0 = *(const u32x4*)sp; xm = (u32x4){0, 0, 0, 0}; xp = (u32x4){0, 0, 0, 0};
    if (pos > 0) xm = *(const u32x4*)(sp - t.lds_);
    if (pos < L - 1) xp = *(const u32x4*)(sp + t.lds_);
}
__device__ void phase_o3(const P& p, unsigned char* sm, int layer, int pass) {
    const int li = layer >> 1, tid = otid();
    unsigned short* sT = (unsigned short*)sm;
    const float* cw = p.ssd_conv_w + (size_t)li * 3 * 4096; const float* cb = p.ssd_conv_b + (size_t)li * 4096;
    const int tl = tid >> 3, c8 = (tid & 7) * 8;
    int t = blockIdx.x; if (t >= 5120) return;
    int cur_ct = -1; f32x4 w0a, w0b, w1a, w1b, w2a, w2b, ba, bb; O3Tile T;
    u32x4 x0, xm, xp;
    { const O3Tile T0 = o3_decode(p.ws, t & 15, pass); o3_load(T0, (t >> 4) * 64 + tl, c8, x0, xm, xp); }
    for (; t < 5120; t += gridDim.x) {
        const int tt = t >> 4, ct = t & 15, tok = tt * 64 + tl;
        if (ct != cur_ct) { cur_ct = ct; T = o3_decode(p.ws, ct, pass); const int cc = T.cch + c8;
            w0a = *(const f32x4*)(cw + cc); w0b = *(const f32x4*)(cw + cc + 4); w1a = *(const f32x4*)(cw + 4096 + cc); w1b = *(const f32x4*)(cw + 4096 + cc + 4);
            w2a = *(const f32x4*)(cw + 8192 + cc); w2b = *(const f32x4*)(cw + 8192 + cc + 4); ba = *(const f32x4*)(cb + cc); bb = *(const f32x4*)(cb + cc + 4); }
        u32x4 n0 = x0, nm = xm, np = xp;
        { const int tn = t + gridDim.x; if (tn < 5120) { const O3Tile TN = o3_decode(p.ws, tn & 15, pass); o3_load(TN, (tn >> 4) * 64 + tl, c8, n0, nm, np); } }
        float r[8];
        r[0] = silu_f(w0a[0] * bflo(xm.x) + w1a[0] * bflo(x0.x) + w2a[0] * bflo(xp.x) + ba[0]);
        r[1] = silu_f(w0a[1] * bfhi(xm.x) + w1a[1] * bfhi(x0.x) + w2a[1] * bfhi(xp.x) + ba[1]);
        r[2] = silu_f(w0a[2] * bflo(xm.y) + w1a[2] * bflo(x0.y) + w2a[2] * bflo(xp.y) + ba[2]);
        r[3] = silu_f(w0a[3] * bfhi(xm.y) + w1a[3] * bfhi(x0.y) + w2a[3] * bfhi(xp.y) + ba[3]);
        r[4] = silu_f(w0b[0] * bflo(xm.z) + w1b[0] * bflo(x0.z) + w2b[0] * bflo(xp.z) + bb[0]);
        r[5] = silu_f(w0b[1] * bfhi(xm.z) + w1b[1] * bfhi(x0.z) + w2b[1] * bfhi(xp.z) + bb[1]);
        r[6] = silu_f(w0b[2] * bflo(xm.w) + w1b[2] * bflo(x0.w) + w2b[2] * bflo(xp.w) + bb[2]);
        r[7] = silu_f(w0b[3] * bfhi(xm.w) + w1b[3] * bfhi(x0.w) + w2b[3] * bfhi(xp.w) + bb[3]);
        u32x4 w; w.x = cvt_pk(r[0], r[1]); w.y = cvt_pk(r[2], r[3]); w.z = cvt_pk(r[4], r[5]); w.w = cvt_pk(r[6], r[7]);
        if (T.dstN) *(u32x4*)(T.dstN + (size_t)tok * T.ldn + (size_t)(T.ch0 + c8) * 2) = w;
        if (T.dstT) {
            unsigned* s32 = (unsigned*)(sT + tl * 66 + c8);
            s32[0] = w.x; s32[1] = w.y; s32[2] = w.z; s32[3] = w.w;
            __syncthreads();
            const int ch = tid >> 3, tg = tid & 7; unsigned short q[8];
#pragma unroll
            for (int i = 0; i < 8; ++i) q[i] = sT[(tg * 8 + i) * 66 + ch];
            u32x4 o; o.x = q[0] | ((unsigned)q[1] << 16); o.y = q[2] | ((unsigned)q[3] << 16); o.z = q[4] | ((unsigned)q[5] << 16); o.w = q[6] | ((unsigned)q[7] << 16);
            *(u32x4*)(T.dstT + ((size_t)(T.ch0 + ch) * TOK + tt * 64 + tg * 8) * 2) = o;
            __syncthreads();
        }
        x0 = n0; xm = nm; xp = np;
    }
}

struct ConvW { f32x4 w0a, w0b, w1a, w1b, w2a, w2b, ba, bb; };
__device__ __forceinline__ ConvW conv_w(const float* cw, const float* cb, int cc) { ConvW w;
    w.w0a = *(const f32x4*)(cw + cc); w.w0b = *(const f32x4*)(cw + cc + 4); w.w1a = *(const f32x4*)(cw + 4096 + cc); w.w1b = *(const f32x4*)(cw + 4096 + cc + 4);
    w.w2a = *(const f32x4*)(cw + 8192 + cc); w.w2b = *(const f32x4*)(cw + 8192 + cc + 4); w.ba = *(const f32x4*)(cb + cc); w.bb = *(const f32x4*)(cb + cc + 4); return w; }
__device__ __forceinline__ u32x4 conv8(const unsigned char* src, int ldsb, int tok, int col, const ConvW& W) {
    const int L = tok < TOKC ? 256 : 2048, pos = tok < TOKC ? (tok & 255) : ((tok - TOKC) & 2047);
    const unsigned char* sp = src + (size_t)tok * ldsb + (size_t)col * 2;
    const u32x4 x0 = *(const u32x4*)sp; u32x4 xm = {0, 0, 0, 0}, xp = {0, 0, 0, 0};
    if (pos > 0) xm = *(const u32x4*)(sp - ldsb);
    if (pos < L - 1) xp = *(const u32x4*)(sp + ldsb);
    float r[8];
    r[0] = silu_f(W.w0a[0] * bflo(xm.x) + W.w1a[0] * bflo(x0.x) + W.w2a[0] * bflo(xp.x) + W.ba[0]);
    r[1] = silu_f(W.w0a[1] * bfhi(xm.x) + W.w1a[1] * bfhi(x0.x) + W.w2a[1] * bfhi(xp.x) + W.ba[1]);
    r[2] = silu_f(W.w0a[2] * bflo(xm.y) + W.w1a[2] * bflo(x0.y) + W.w2a[2] * bflo(xp.y) + W.ba[2]);
    r[3] = silu_f(W.w0a[3] * bfhi(xm.y) + W.w1a[3] * bfhi(x0.y) + W.w2a[3] * bfhi(xp.y) + W.ba[3]);
    r[4] = silu_f(W.w0b[0] * bflo(xm.z) + W.w1b[0] * bflo(x0.z) + W.w2b[0] * bflo(xp.z) + W.bb[0]);
    r[5] = silu_f(W.w0b[1] * bfhi(xm.z) + W.w1b[1] * bfhi(x0.z) + W.w2b[1] * bfhi(xp.z) + W.bb[1]);
    r[6] = silu_f(W.w0b[2] * bflo(xm.w) + W.w1b[2] * bflo(x0.w) + W.w2b[2] * bflo(xp.w) + W.bb[2]);
    r[7] = silu_f(W.w0b[3] * bfhi(xm.w) + W.w1b[3] * bfhi(x0.w) + W.w2b[3] * bfhi(xp.w) + W.bb[3]);
    u32x4 w; w.x = cvt_pk(r[0], r[1]); w.y = cvt_pk(r[2], r[3]); w.z = cvt_pk(r[4], r[5]); w.w = cvt_pk(r[6], r[7]); return w;
}
__device__ __forceinline__ void conv_c_tile(const P& p, LAS unsigned char* lds, int ldsoff, int li, int pass, int gl, int tok0, int tid, unsigned char* gcopy) {
    const float* cw = p.ssd_conv_w + (size_t)li * 3 * 4096; const float* cb = p.ssd_conv_b + (size_t)li * 4096;
    const int c8 = (tid & 15) * 8; const ConvW W = conv_w(cw, cb, 3072 + 256 * pass + gl * 128 + c8);
#pragma unroll
    for (int k = 0; k < 4; ++k) { const int l = (tid >> 4) + 32 * k;
        const u32x4 v = conv8(p.ws + O_RAWC, 512, tok0 + l, gl * 128 + c8, W);
        int ob = (l & 15) * 64 + (c8 & 31) * 2; ob ^= ((ob >> 9) & 1) << 5;
        *(LAS u32x4*)(lds + ldsoff + ((l >> 4) * 4 + (c8 >> 5)) * 1024 + ob) = v;
        if (gcopy) *(u32x4*)(gcopy + ((size_t)(tok0 + l) * 256 + gl * 128 + c8) * 2) = v; }
}
constexpr int L_C = 0, L_B = 32768, L_X = 65536, L_DT = 131072, L_CUM = 135168, L_SS = 139264, L_CF = 139264, L_WT = 143360;
__device__ __forceinline__ bf16x8 scale8(bf16x8 x, f32x4 wa, f32x4 wb) {
    union { bf16x8 v; u32x4 u; } r;
    r.u.x = cvt_pk(bf2f(x[0]) * wa[0], bf2f(x[1]) * wa[1]); r.u.y = cvt_pk(bf2f(x[2]) * wa[2], bf2f(x[3]) * wa[3]);
    r.u.z = cvt_pk(bf2f(x[4]) * wb[0], bf2f(x[5]) * wb[1]); r.u.w = cvt_pk(bf2f(x[6]) * wb[2], bf2f(x[7]) * wb[3]);
    return r.v;
}
__device__ void phase_s1(const P& p, unsigned char* sm, LAS unsigned char* lds, int layer, int pass) {
    const int li = layer >> 1, tid = otid(), wid = __builtin_amdgcn_readfirstlane(tid >> 6), lane = tid & 63, fr = lane & 15, fq = lane >> 4;
    const int fo = frag_off(fr, fq);
    float* sDT = (float*)(sm + L_DT); float* sCUM = (float*)(sm + L_CUM); float* sCF = (float*)(sm + L_CF); float* sWT = (float*)(sm + L_WT);
    unsigned char* ws = p.ws;
    const int G_ = (int)gridDim.x, wdx = (G_ & 7) == 0 ? ((int)blockIdx.x & 7) * (G_ >> 3) + ((int)blockIdx.x >> 3) : (int)blockIdx.x;
    const int per = (1280 + G_ - 1) / G_, hi_lo = wdx * per, hi_hi = hi_lo + per < 1280 ? hi_lo + per : 1280;
    int cur_item = -1;
    for (int hi = hi_lo; hi < hi_hi; ++hi) {
        const int item = hi >> 2, r = hi & 3;
        const int chunk = item >> 1, gl = item & 1, tok0 = chunk * 128, g = pass * 2 + gl;
        if (item != cur_item) {
            cur_item = item;
            __syncthreads();
            conv_c_tile(p, lds, L_C, li, pass, gl, tok0, tid, ws + O_CS);
            { const float* cw = p.ssd_conv_w + (size_t)li * 3 * 4096; const float* cb = p.ssd_conv_b + (size_t)li * 4096;
              { const int c8 = (tid & 15) * 8; const ConvW W = conv_w(cw, cb, 2048 + 256 * pass + gl * 128 + c8);
#pragma unroll
                for (int k = 0; k < 4; ++k) { const int l = (tid >> 4) + 32 * k;
                    *(LAS u32x4*)(lds + L_B + off_b(l, c8 >> 3)) = conv8(ws + O_RAWB, 512, tok0 + l, gl * 128 + c8, W); } }
              { const int r_first = hi & 3, n_here = hi_hi - hi, r_last = r_first + n_here - 1 < 3 ? r_first + n_here - 1 : 3;
                for (int rr = r_first; rr <= r_last; ++rr) { const int c8 = rr * 64 + (tid & 7) * 8; const ConvW W = conv_w(cw, cb, 512 * pass + gl * 256 + c8);
#pragma unroll
                    for (int k = 0; k < 2; ++k) { const int l = (tid >> 3) + 64 * k;
                        *(LAS u32x4*)(lds + L_X + (c8 >> 7) * 32768 + off_b(l, (c8 & 127) >> 3)) = conv8(ws + O_RAWX, 1024, tok0 + l, gl * 256 + c8, W); } } } }
            { const int r4 = tid >> 7, pos = tid & 127, h = g * 4 + r4; const float* dr = (const float*)(ws + O_DTR) + (size_t)(tok0 + pos) * 64;
#pragma unroll
              for (int d = 0; d < 2; ++d) { const float raw = dr[d * 32 + h] + p.ssd_dt_bias[(li * 2 + d) * 32 + h];
                  const float dt = raw > 20.f ? raw : log1pf(__expf(raw)); const float a = -__expf(p.ssd_a_log[(li * 2 + d) * 32 + h]);
                  sDT[(r4 * 2 + d) * 128 + pos] = dt; sCUM[(r4 * 2 + d) * 128 + pos] = dt * a; } }
            __syncthreads();
            { float* cu = sCUM + wid * 128; const int d = wid & 1, r4 = wid >> 1, hl = gl * 4 + r4; const int e0 = d ? 127 - 2 * lane : 2 * lane, e1 = d ? e0 - 1 : e0 + 1;
              const float v0 = cu[e0], v1 = cu[e1], sv = v0 + v1; float inc = sv;
#pragma unroll
              for (int o = 1; o < 64; o <<= 1) { const float t = __shfl_up(inc, o); if (lane >= o) inc += t; }
              const float exc = inc - sv, c0 = exc + v0, c1 = exc + sv; cu[e0] = c0; cu[e1] = c1;
              float* CUMG = (float*)(ws + O_CUM);
              CUMG[((size_t)(tok0 + e0) * 2 + d) * 8 + hl] = c0; CUMG[((size_t)(tok0 + e1) * 2 + d) * 8 + hl] = c1;
              if (lane == 63) ((float*)(ws + O_DEC))[(chunk * 2 + d) * 8 + hl] = __expf(inc); }
            __syncthreads();
#pragma unroll
            for (int q = 0; q < 2; ++q) { const int idx = tid + q * 512, w8 = idx >> 7, pos = idx & 127, d = w8 & 1; const float* cu = sCUM + w8 * 128;
                const float cv = cu[pos], dtv = sDT[idx], ref = d ? cu[pos | 7] : cu[pos & ~7], tot = d ? cu[0] : cu[127];
                sCF[idx] = dtv * __expf(fminf(ref - cv, 80.f)); sWT[idx] = dtv * __expf(tot - cv); }
            { f32x4 cb[8];
#pragma unroll
              for (int st = 0; st < 8; ++st) cb[st] = (f32x4){0.f, 0.f, 0.f, 0.f};
#pragma unroll
              for (int kb = 0; kb < 4; ++kb) { const bf16x8 cf = LDFRAG(lds, L_C + (wid * 4 + kb) * 1024 + fo);
#pragma unroll
                  for (int st = 0; st < 8; ++st) { const bf16x8 bfr = LDFRAG(lds, L_B + off_b(16 * st + fr, 4 * kb + fq)); cb[st] = MFMA(bfr, cf, cb[st]); } }
              __syncthreads();
#pragma unroll
              for (int st = 0; st < 8; ++st) { int ob = fr * 64 + ((st & 1) * 16 + 4 * fq) * 2; ob ^= ((ob >> 9) & 1) << 5;
                  u32x2 w; w.x = cvt_pk(cb[st][0], cb[st][1]); w.y = cvt_pk(cb[st][2], cb[st][3]);
                  *(LAS u32x2*)(lds + L_C + (wid * 4 + (st >> 1)) * 1024 + ob) = w; } }
            __syncthreads();
        }
        { const int lt = wid, h = g * 4 + r; const float Dh = p.ssd_d[li * 32 + h];
          const float* cF = sCUM + (r * 2) * 128; const float* cR = cF + 128; const float* kF = sCF + (r * 2) * 128; const float* kR = kF + 128;
          f32x4 acc[4];
#pragma unroll
          for (int pt = 0; pt < 4; ++pt) acc[pt] = (f32x4){0.f, 0.f, 0.f, 0.f};
          const int l = lt * 16 + fr; const float cfl = cF[l], crl = cR[l];
#pragma unroll 1
          for (int kb = 0; kb < 4; ++kb) { const bf16x8 cbf = LDFRAG(lds, L_C + (lt * 4 + kb) * 1024 + fo); const int s0 = kb * 32 + fq * 8;
              bf16x8 xa[4];
#pragma unroll
              for (int pt = 0; pt < 4; ++pt) xa[pt] = trfrag(lds + L_X + (r >> 1) * 32768, lane, (r & 1) * 4 + pt, kb);
              const int rel = lt - 2 * kb;
              float mv[8];
              if (rel >= 2) { const float rf = __expf(cfl - cF[s0]); const f32x4 ka = *(const f32x4*)(kF + s0), kb4 = *(const f32x4*)(kF + s0 + 4);
#pragma unroll
                  for (int j = 0; j < 4; ++j) { mv[j] = bf2f(cbf[j]) * (rf * ka[j]); mv[4 + j] = bf2f(cbf[4 + j]) * (rf * kb4[j]); }
              } else if (rel < 0) { const float rr = __expf(crl - cR[s0 + 7]); const f32x4 ka = *(const f32x4*)(kR + s0), kb4 = *(const f32x4*)(kR + s0 + 4);
#pragma unroll
                  for (int j = 0; j < 4; ++j) { mv[j] = bf2f(cbf[j]) * (rr * ka[j]); mv[4 + j] = bf2f(cbf[4 + j]) * (rr * kb4[j]); }
              } else { const float rf = __expf(fminf(cfl - cF[s0], 0.f)), rr = __expf(fminf(crl - cR[s0 + 7], 0.f)), dsum = sDT[(r * 2) * 128 + l] + sDT[(r * 2 + 1) * 128 + l];
                  const f32x4 fa = *(const f32x4*)(kF + s0), fb = *(const f32x4*)(kF + s0 + 4), ra = *(const f32x4*)(kR + s0), rb = *(const f32x4*)(kR + s0 + 4);
#pragma unroll
                  for (int j = 0; j < 8; ++j) { const int sidx = s0 + j; const float kf = j < 4 ? fa[j & 3] : fb[j & 3], kr = j < 4 ? ra[j & 3] : rb[j & 3];
                      const float wgt = sidx < l ? rf * kf : (sidx > l ? rr * kr : dsum);
                      mv[j] = bf2f(cbf[j]) * wgt + (sidx == l ? Dh : 0.f); } }
              union { bf16x8 v; u32x4 u; } mf; mf.u.x = cvt_pk(mv[0], mv[1]); mf.u.y = cvt_pk(mv[2], mv[3]); mf.u.z = cvt_pk(mv[4], mv[5]); mf.u.w = cvt_pk(mv[6], mv[7]);
#pragma unroll
              for (int pt = 0; pt < 4; ++pt) acc[pt] = MFMA(xa[pt], mf.v, acc[pt]); }
          unsigned char* yp = ws + O_YD + ((size_t)(tok0 + l) * 512 + gl * 256 + r * 64 + 4 * fq) * 2;
#pragma unroll
          for (int pt = 0; pt < 4; ++pt) { u32x2 w; w.x = cvt_pk(acc[pt][0], acc[pt][1]); w.y = cvt_pk(acc[pt][2], acc[pt][3]); *(u32x2*)(yp + pt * 32) = w; } }
        { const int d = wid & 1, pq = wid >> 1, hl = gl * 4 + r; const float* wt = sWT + (r * 2 + d) * 128;
          f32x4 acc[8];
#pragma unroll
          for (int a = 0; a < 8; ++a) acc[a] = (f32x4){0.f, 0.f, 0.f, 0.f};
#pragma unroll
          for (int kb = 0; kb < 4; ++kb) { const int l0 = kb * 32 + fq * 8; const f32x4 wa = *(const f32x4*)(wt + l0), wb = *(const f32x4*)(wt + l0 + 4);
              const bf16x8 xb = scale8(trfrag(lds + L_X + (r >> 1) * 32768, lane, (r & 1) * 4 + pq, kb), wa, wb);
#pragma unroll
              for (int n2 = 0; n2 < 8; ++n2) { const bf16x8 af = trfrag(lds + L_B, lane, n2, kb); acc[n2] = MFMA(af, xb, acc[n2]); } }
          unsigned char* sp = ws + O_ST + ((size_t)((chunk * 2 + d) * 8 + hl) * 64) * 256;
#pragma unroll
          for (int n2 = 0; n2 < 8; ++n2) { u32x2 w; w.x = cvt_pk(acc[n2][0], acc[n2][1]); w.y = cvt_pk(acc[n2][2], acc[n2][3]);
              *(u32x2*)(sp + ((size_t)(pq * 16 + fr) * 128 + n2 * 16 + 4 * fq) * 2) = w; } }
    }
}
__device__ void phase_s2(const P& p, int layer, int pass) {
    const int li = layer >> 1; unsigned char* ws = p.ws;
    const long gt = (long)blockIdx.x * 512 + otid(), gn = (long)gridDim.x * 512;
    const float* DEC = (const float*)(ws + O_DEC);
    for (long it = gt; it < 393216; it += gn) {
        const int n8 = (int)(it & 15), pp = (int)(it >> 4) & 63, hl = (int)(it >> 10) & 7, d = (int)(it >> 13) & 1, seq = (int)(it >> 14);
        const int nc = seq < 16 ? 2 : 16, c0 = seq < 16 ? seq * 2 : 32 + (seq - 16) * 16, h = pass * 8 + hl;
        f32x4 ha = (f32x4){0.f, 0.f, 0.f, 0.f}, hb = ha;
        if (seq >= 16) { const float* s0 = p.state + ((((size_t)(seq - 16) * 2 + li) * 2 + d) * 32 + h) * 8192 + pp * 128 + n8 * 8; ha = *(const f32x4*)s0; hb = *(const f32x4*)(s0 + 4); }
        const int nb = nc < 4 ? nc : 4;
        for (int k0 = 0; k0 < nc; k0 += nb) {
            u32x4 sv[4]; float dc[4]; unsigned char* pt[4];
#pragma unroll
            for (int j = 0; j < 4; ++j) if (j < nb) { const int k = k0 + j, c = d ? c0 + nc - 1 - k : c0 + k; dc[j] = DEC[(c * 2 + d) * 8 + hl];
                pt[j] = ws + O_ST + (((size_t)((c * 2 + d) * 8 + hl) * 64 + pp) * 128 + n8 * 8) * 2; sv[j] = *(const u32x4*)pt[j]; }
#pragma unroll
            for (int j = 0; j < 4; ++j) if (j < nb) { const float dec = dc[j];
                u32x4 w; w.x = cvt_pk(ha[0], ha[1]); w.y = cvt_pk(ha[2], ha[3]); w.z = cvt_pk(hb[0], hb[1]); w.w = cvt_pk(hb[2], hb[3]);
                *(u32x4*)pt[j] = w;
                ha[0] = ha[0] * dec + bflo(sv[j].x); ha[1] = ha[1] * dec + bfhi(sv[j].x); ha[2] = ha[2] * dec + bflo(sv[j].y); ha[3] = ha[3] * dec + bfhi(sv[j].y);
                hb[0] = hb[0] * dec + bflo(sv[j].z); hb[1] = hb[1] * dec + bfhi(sv[j].z); hb[2] = hb[2] * dec + bflo(sv[j].w); hb[3] = hb[3] * dec + bfhi(sv[j].w); } }
        if (seq < 16) { float* o = p.out + OUT_STATE_OFF + ((((size_t)seq * 2 + li) * 2 + d) * 32 + h) * 8192 + pp * 128 + n8 * 8; *(f32x4*)o = ha; *(f32x4*)(o + 4) = hb; }
    }
}
__device__ void phase_s3(const P& p, unsigned char* sm, LAS unsigned char* lds, int layer, int pass) {
    const int li = layer >> 1, tid = otid(), wid = __builtin_amdgcn_readfirstlane(tid >> 6), lane = tid & 63, fr = lane & 15, fq = lane >> 4;
    const int fo = frag_off(fr, fq);
    float* sSC = (float*)(sm + L_DT); float* sSS = (float*)(sm + L_SS);
    unsigned char* ws = p.ws;
    const int G_ = (int)gridDim.x, wdx = (G_ & 7) == 0 ? ((int)blockIdx.x & 7) * (G_ >> 3) + ((int)blockIdx.x >> 3) : (int)blockIdx.x;
    const int per = (1280 + G_ - 1) / G_, q_lo = wdx * per, q_hi = q_lo + per < 1280 ? q_lo + per : 1280;
    const int r = wid >> 1, ph = wid & 1;
    int cur_item = -1;
    bf16x8 hh[2][4][2];
#pragma unroll
    for (int d = 0; d < 2; ++d)
#pragma unroll
        for (int kb = 0; kb < 4; ++kb) { hh[d][kb][0] = (bf16x8){0, 0, 0, 0, 0, 0, 0, 0}; hh[d][kb][1] = hh[d][kb][0]; }
    for (int qi = q_lo; qi < q_hi; ++qi) {
        const int item = qi >> 2, lq = qi & 3;
        const int chunk = item >> 1, gl = item & 1, tok0 = chunk * 128, g = pass * 2 + gl;
        if (item != cur_item) {
            cur_item = item;
            __syncthreads();
            stage_tile(lds, L_C, ws + O_CS + ((size_t)tok0 * 256 + gl * 128) * 2, 512, 8, 4, wid, lane);
            { const unsigned char* hin0 = ws + O_ST + ((size_t)((chunk * 2) * 8 + gl * 4 + r) * 64 + ph * 32) * 256 + ((size_t)fr * 128 + fq * 8) * 2;
#pragma unroll
              for (int d = 0; d < 2; ++d)
#pragma unroll
                  for (int kb = 0; kb < 4; ++kb) { hh[d][kb][0] = *(const bf16x8*)(hin0 + (size_t)d * 131072 + kb * 64); hh[d][kb][1] = *(const bf16x8*)(hin0 + (size_t)d * 131072 + kb * 64 + 16 * 256); } }
            { const float* CUMG = (const float*)(ws + O_CUM);
#pragma unroll
              for (int q = 0; q < 2; ++q) { const int idx = tid + q * 512, l = idx & 127, w8 = idx >> 7, r4 = w8 >> 1, d = w8 & 1;
                  sSC[w8 * 128 + l] = __expf(CUMG[((size_t)(tok0 + l) * 2 + d) * 8 + gl * 4 + r4]); } }
            asm volatile("s_waitcnt vmcnt(0)" ::: "memory"); __syncthreads();
        }
        f32x4 acc[2][2], aR[2][2], ggv[2];
        { const float* ng = p.ssd_norm_g + (size_t)li * 2048 + g * 256 + r * 64 + ph * 32 + 4 * fq; ggv[0] = *(const f32x4*)ng; ggv[1] = *(const f32x4*)(ng + 16); }
        u32x2 ydv[2][2], zzv[2][2];
#pragma unroll
        for (int i = 0; i < 2; ++i)
#pragma unroll
            for (int pt = 0; pt < 2; ++pt) { const size_t o = ((size_t)(tok0 + (lq * 2 + i) * 16 + fr) * 512 + gl * 256 + r * 64 + ph * 32 + pt * 16 + 4 * fq) * 2;
                ydv[i][pt] = *(const u32x2*)(ws + O_YD + o); zzv[i][pt] = *(const u32x2*)(ws + O_Z + o); }
#pragma unroll
        for (int i = 0; i < 2; ++i) { acc[i][0] = (f32x4){0.f, 0.f, 0.f, 0.f}; acc[i][1] = acc[i][0]; aR[i][0] = acc[i][0]; aR[i][1] = acc[i][0]; }
#pragma unroll
        for (int kb = 0; kb < 4; ++kb)
#pragma unroll
            for (int i = 0; i < 2; ++i) { const bf16x8 cf = LDFRAG(lds, L_C + ((lq * 2 + i) * 4 + kb) * 1024 + fo);
                acc[i][0] = MFMA(hh[0][kb][0], cf, acc[i][0]); acc[i][1] = MFMA(hh[0][kb][1], cf, acc[i][1]);
                aR[i][0] = MFMA(hh[1][kb][0], cf, aR[i][0]); aR[i][1] = MFMA(hh[1][kb][1], cf, aR[i][1]); }
#pragma unroll
        for (int i = 0; i < 2; ++i) { const int l = (lq * 2 + i) * 16 + fr; float ss = 0.f;
            const float sf = sSC[(r * 2) * 128 + l], sr = sSC[(r * 2 + 1) * 128 + l];
#pragma unroll
            for (int pt = 0; pt < 2; ++pt) { const u32x2 yd = ydv[i][pt], zz = zzv[i][pt];
                f32x4 v = acc[i][pt] * sf + aR[i][pt] * sr;
                v[0] = (v[0] + bflo(yd.x)) * silu_f(bflo(zz.x)); v[1] = (v[1] + bfhi(yd.x)) * silu_f(bfhi(zz.x));
                v[2] = (v[2] + bflo(yd.y)) * silu_f(bflo(zz.y)); v[3] = (v[3] + bfhi(yd.y)) * silu_f(bfhi(zz.y));
                acc[i][pt] = v; ss += v[0] * v[0] + v[1] * v[1] + v[2] * v[2] + v[3] * v[3]; }
            ss += __shfl_xor(ss, 16); ss += __shfl_xor(ss, 32);
            if (fq == 0) sSS[(qi & 1) * 256 + wid * 32 + i * 16 + fr] = ss; }
        __syncthreads();
#pragma unroll
        for (int i = 0; i < 2; ++i) { const int l = (lq * 2 + i) * 16 + fr; float tot = 0.f;
#pragma unroll
            for (int w = 0; w < 8; ++w) tot += sSS[(qi & 1) * 256 + w * 32 + i * 16 + fr];
            const float rstd = rsqrtf(tot * (1.0f / 256.f) + 1e-6f);
#pragma unroll
            for (int pt = 0; pt < 2; ++pt) { const f32x4 gg = ggv[pt]; const f32x4 v = acc[i][pt];
                u32x2 w; w.x = cvt_pk(v[0] * rstd * gg[0], v[1] * rstd * gg[1]); w.y = cvt_pk(v[2] * rstd * gg[2], v[3] * rstd * gg[3]);
                *(u32x2*)(ws + O_YN + ((size_t)(tok0 + l) * 2048 + g * 256 + r * 64 + ph * 32 + pt * 16 + 4 * fq) * 2) = w; } }
    }
}
__device__ void phase_final(const P& p) {
    const int tid = otid(), lane = tid & 63, gw = blockIdx.x * 8 + (tid >> 6), nw = gridDim.x * 8;
    const int rpw = (TOK + nw - 1) / nw, r_lo = gw * rpw, r_hi = r_lo + rpw < TOK ? r_lo + rpw : TOK;
    f32x4 g[4];
#pragma unroll
    for (int i = 0; i < 4; ++i) g[i] = *(const f32x4*)(p.final_norm_g + i * 256 + lane * 4);
    for (int t0 = r_lo; t0 < r_hi; t0 += 4) {
        f32x4 v[4][4]; float ss[4];
#pragma unroll
        for (int j = 0; j < 4; ++j) { const int t = t0 + j < r_hi ? t0 + j : r_hi - 1; const float* xr = p.out + (size_t)t * 1024;
#pragma unroll
            for (int i = 0; i < 4; ++i) v[j][i] = *(const f32x4*)(xr + i * 256 + lane * 4); }
#pragma unroll
        for (int j = 0; j < 4; ++j) { float a = 0.f;
#pragma unroll
            for (int i = 0; i < 4; ++i) a += v[j][i][0] * v[j][i][0] + v[j][i][1] * v[j][i][1] + v[j][i][2] * v[j][i][2] + v[j][i][3] * v[j][i][3];
            ss[j] = a; }
#pragma unroll
        for (int o = 32; o >= 1; o >>= 1) {
#pragma unroll
            for (int j = 0; j < 4; ++j) ss[j] += __shfl_xor(ss[j], o); }
#pragma unroll
        for (int j = 0; j < 4; ++j) if (t0 + j < r_hi) { const float rstd = rsqrtf(ss[j] * (1.0f / 1024.f) + 1e-6f); float* xr = p.out + (size_t)(t0 + j) * 1024;
#pragma unroll
            for (int i = 0; i < 4; ++i) *(f32x4*)(xr + i * 256 + lane * 4) = v[j][i] * rstd * g[i]; }
    }
}

__global__ void __launch_bounds__(512, 2) mega(P p) {
    extern __shared__ __attribute__((aligned(16))) unsigned char smem[];
    LAS unsigned char* lds = (LAS unsigned char*)smem;
    cg::grid_group grid = cg::this_grid();
    XcdBarrier xb; xb.bar = (unsigned*)(p.ws + WS_BAR); xb.x = xb_xcc_id(); xb.st = (volatile LAS unsigned*)(lds + 147456);
    if (threadIdx.x == 0) { xb.st[0] = 0u; xb.st[1] = 0u; (void)xb_add(&xb.bar[XB_XCNT(xb.x)], 1u); }
    __syncthreads();
    const int G = gridDim.x, c = blockIdx.x;
    if (p.ph0 < 0) grid.sync();
#ifndef REP_MASK
#define REP_MASK 0
#endif
    for (int ph = p.ph0; ph < p.ph1; ++ph) {
        int kind, layer = 0, pass = 0;
        if (ph < 2) kind = ph;
        else if (ph == 54) kind = 13;
        else { const int q = ph - 2, blk = q / 26; int r = q - blk * 26; layer = blk * 2;
            if (r < 8) { if (r < 6) { pass = r / 3; kind = 2 + (r - pass * 3); } else kind = r == 6 ? 5 : 6; }
            else { r -= 8; layer += 1; if (r == 0) kind = 7; else if (r == 17) kind = 6; else { pass = (r - 1) / 4; const int sub = r - 1 - pass * 4; kind = sub == 0 ? 8 : 9 + sub; } } }
        const int cls = (kind == 3 || kind == 8) ? 1 : kind == 5 ? 2 : kind == 4 ? 4 : kind == 9 ? 8 : kind == 10 ? 16 : kind == 12 ? 32 : (kind == 2 || kind == 7) ? 64 : kind < 2 ? 128 : 0;
        const int nrep = ((REP_MASK) & cls) ? 2 : 1;
        bool skip_bar = false;
        for (int rep = 0; rep < nrep; ++rep) {
            if (rep) grid_barrier(xb);
            switch (kind) {
            case 0: phase_prep0(p, smem); break;
            case 1: { UF_Prep1 uf{p.ws, G, c}; gemm_phase<true>(lds, 512, 2048, 4, 1 << 30, 0L, 0L, uf, EpiBf16{}); __syncthreads(); phase_normE(p, smem, 0, 0); } break;
            case 2: if ((layer == 0 && pass == 0) || pass == 1) skip_bar = true; else phase_normE(p, smem, layer, pass); break;
            case 3: { UF_G1E uf{&p, layer >> 1, pass, G, c}; gemm_phase<true>(lds, 2048, 2048, 16, 1 << 30, 0L, 0L, uf, EpiBf16{}); } break;
            case 4: phase_e3(p, layer, pass); if (pass == 0) phase_normE(p, smem, layer, 1); break;
            case 5: { UF_E4L uf{&p, G, c}; gemm_phase<true>(lds, 4096, 8192, 32, 16, 0L, 2048L, uf, EpiBf16{});
                      UF_E4C uc{&p, G, c}; gemm_phase<true>(lds, 1024, 1024, 8, 1 << 30, 0L, 0L, uc, EpiBf16{}); } break;
            case 6: { const bool even = (layer & 1) == 0; const int lda = even ? 2048 : 4096, tseg = even ? 16 : (1 << 30); const long segoff = even ? (long)(E_YB - E_YA) - 2048L : 0L;
                      UF_G2 uf{&p, layer, 0, G, c}; gemm_phase<false, false>(lds, lda, 4096, 32, tseg, segoff, 0L, uf, EpiResT<false>{});
                      UF_G2 uh{&p, layer, 1, G, c}; gemm_phase<false, true>(lds, lda, 4096, 32, tseg, segoff, 0L, uh, EpiResT<true>{});
                      if (layer < 3) {
                          const int nh = G > 128 ? 128 : 0, rank = c - nh, nblk = G - nh;
                          if (rank >= 0) { __syncthreads(); if (even) conv_odd(p, smem, layer + 1, rank, nblk); else conv_even(p, smem, layer + 1, rank, nblk); } } } break;
            case 7: phase_normO(p, smem, layer); break;
            case 8: { UF_G1O uf{p.ws, pass, pass == 0 ? 7 : 6, G, c}; gemm_phase<true>(lds, 2048, 2048, 16, 1 << 30, 0L, 0L, uf, EpiBf16{}); } break;
            case 9: phase_o3(p, smem, layer, pass); break;
            case 10: phase_s1(p, smem, lds, layer, pass); break;
            case 11: phase_s2(p, layer, pass); break;
            case 12: phase_s3(p, smem, lds, layer, pass); break;
            default: phase_final(p); break;
            }
        }
        if (!skip_bar && ph + 1 < p.ph1) { grid_barrier(xb); if ((REP_MASK) & 512) grid_barrier(xb); }
    }
}
constexpr int N_PHASES = 55;

extern "C" void kernel_launch(void* const* d_in, const int* in_sizes, int n_in, void* d_out, int out_size, void* d_ws, size_t ws_size, hipStream_t stream) {
    static int grid = 0;
    if (grid == 0) {
        if (ws_size < WS_NEED) { fprintf(stderr, "kernel_launch: workspace too small: %zu < %zu\n", ws_size, (size_t)WS_NEED); grid = -1; return; }
        int dev = 0, cus = 0, per_cu = 0;
        hipGetDevice(&dev); hipDeviceGetAttribute(&cus, hipDeviceAttributeMultiprocessorCount, dev);
        hipFuncSetAttribute((const void*)mega, hipFuncAttributeMaxDynamicSharedMemorySize, LDS_BYTES);
        hipOccupancyMaxActiveBlocksPerMultiprocessor(&per_cu, (const void*)mega, 512, LDS_BYTES);
        if (per_cu < 1) { fprintf(stderr, "kernel_launch: occupancy query says %d blocks per CU\n", per_cu); grid = -1; return; }
        grid = cus;
        if (grid > 256) grid = 256;
    }
    if (grid < 0) return;
    hipMemsetAsync((char*)d_ws + WS_BAR, 0, 16384, stream);
    P p{};
    const float** pp = (const float**)&p;
    for (int i = 0; i < 20; ++i) pp[i] = (const float*)d_in[i];
    p.out = (float*)d_out; p.ws = (unsigned char*)d_ws; p.ph0 = 0; p.ph1 = N_PHASES;
#ifdef DBG_PH1
    p.ph1 = DBG_PH1;
#endif
    void* args[] = {&p};
    hipError_t e = hipLaunchCooperativeKernel((const void*)mega, dim3(grid), dim3(512), args, LDS_BYTES, stream);
    if (e != hipSuccess) fprintf(stderr, "cooperative launch failed: %s (grid %d)\n", hipGetErrorString(e), grid);
}
```
